# Optimizing an MI355X kernel written in HIP

```python
import jax, jax.numpy as jnp
from jax import lax
import numpy as np

D_MODEL = 1024
BATCH = 4
SEQ = 4096
DEPTH = 4

GRID_W = 64
CTX_LEN = 256
HEAD_DIM = 64
N_HEADS = D_MODEL // HEAD_DIM
A_HEADS = 3 * N_HEADS // 8
A_KV = 2
B_HEADS = N_HEADS // 4
C_HEADS = N_HEADS - A_HEADS - B_HEADS
C_KV = 2
MIX_WIDTH = N_HEADS * HEAD_DIM
WINDOW = 128
A_BLOCK = 128
NA_KH = 8
NA_KW = 16
NA_QCOLS = 16
NA_SLAB = NA_QCOLS + NA_KW
C_BLOCK = 128
FFN_HIDDEN = ((8 * D_MODEL + 3 * 256 - 1) // (3 * 256)) * 256
ROPE_THETA = 10000.0
EPS = 1e-6
NEG_INF = -1e30
_IN_WIDTHS = (A_HEADS * HEAD_DIM, A_KV * HEAD_DIM, A_KV * HEAD_DIM,
              B_HEADS * HEAD_DIM, B_HEADS * HEAD_DIM, B_HEADS * HEAD_DIM,
              C_HEADS * HEAD_DIM, C_KV * HEAD_DIM, C_KV * HEAD_DIM)
IN_WIDTH = sum(_IN_WIDTHS)
IN_SPLIT_POINTS = tuple(int(v) for v in np.cumsum(_IN_WIDTHS)[:-1])

kernel_name = 'hymba_style_diffusion_hybrid_block'


def rms_norm(x, g):
    xf = x.astype(jnp.float32)
    y = xf * lax.rsqrt(jnp.mean(xf * xf, axis=-1, keepdims=True) + EPS)
    return (y * g.astype(jnp.float32)).astype(x.dtype)


def modulate(h, shift, scale):
    return h * (1 + scale) + shift


def axial_rope_tables(L):
    t = jnp.arange(L, dtype=jnp.int32)
    row = (t // GRID_W).astype(jnp.float32)
    col = (t % GRID_W).astype(jnp.float32)
    n_freq = HEAD_DIM // 4
    inv = ROPE_THETA ** (-jnp.arange(n_freq, dtype=jnp.float32) / n_freq)
    ang = jnp.concatenate([row[:, None] * inv[None, :], col[:, None] * inv[None, :]], axis=-1)
    return jnp.cos(ang), jnp.sin(ang)


def apply_rope(x, cos, sin):
    half = HEAD_DIM // 2
    shape = (cos.shape[0],) + (1,) * (x.ndim - 3) + (half,)
    cos = cos.reshape(shape).astype(x.dtype)
    sin = sin.reshape(shape).astype(x.dtype)
    x1, x2 = x[..., :half], x[..., half:]
    return jnp.concatenate([x1 * cos - x2 * sin, x2 * cos + x1 * sin], axis=-1)


def split_mixer_inputs(proj, qk_g):
    B, L, _ = proj.shape
    hd = HEAD_DIM
    q_w, k_w, v_w, q_n, k_n, v_n, q_g, k_g, v_g = jnp.split(proj, IN_SPLIT_POINTS, axis=-1)
    q_w = rms_norm(q_w.reshape(B, L, A_KV, A_HEADS // A_KV, hd), qk_g[0])
    k_w = rms_norm(k_w.reshape(B, L, A_KV, hd), qk_g[1])
    v_w = v_w.reshape(B, L, A_KV, hd)
    q_n = rms_norm(q_n.reshape(B, L, B_HEADS, 1, hd), qk_g[2])
    k_n = rms_norm(k_n.reshape(B, L, B_HEADS, hd), qk_g[3])
    v_n = v_n.reshape(B, L, B_HEADS, hd)
    q_g = rms_norm(q_g.reshape(B, L, C_KV, C_HEADS // C_KV, hd), qk_g[4])
    k_g = rms_norm(k_g.reshape(B, L, C_KV, hd), qk_g[5])
    v_g = v_g.reshape(B, L, C_KV, hd)
    return q_w, k_w, v_w, q_n, k_n, v_n, q_g, k_g, v_g


def context_attention(q, k, v, sink=None):
    B, Lq, Hkv, G, dh = q.shape
    s = jnp.einsum('bqhgd,bkhd->bhgqk', q, k).astype(jnp.float32) * (dh ** -0.5)
    if sink is not None:
        s_sink = jnp.broadcast_to(sink.astype(jnp.float32).reshape(1, Hkv, G, 1, 1), s.shape[:-1] + (1,))
        s = jnp.concatenate([s, s_sink], axis=-1)
    p = jax.nn.softmax(s, axis=-1)[..., :k.shape[1]].astype(v.dtype)
    o = jnp.einsum('bhgqk,bkhd->bqhgd', p, v)
    return o.reshape(B, Lq, Hkv * G * dh)


def window_attention(q, k, v, kt, vt, sink):
    B, L, Hkv, G, dh = q.shape
    nb = L // A_BLOCK
    qb = q.reshape(B, nb, A_BLOCK, Hkv, G, dh)
    pad = ((0, 0), (A_BLOCK, A_BLOCK), (0, 0), (0, 0))
    kp = jnp.pad(k, pad).reshape(B, nb + 2, A_BLOCK, Hkv, dh)
    vp = jnp.pad(v, pad).reshape(B, nb + 2, A_BLOCK, Hkv, dh)
    kb = jnp.concatenate([kp[:, :-2], kp[:, 1:-1], kp[:, 2:]], axis=2)
    vb = jnp.concatenate([vp[:, :-2], vp[:, 1:-1], vp[:, 2:]], axis=2)
    qpos = jnp.arange(L).reshape(nb, A_BLOCK)
    kpos = jnp.arange(nb)[:, None] * A_BLOCK + jnp.arange(-A_BLOCK, 2 * A_BLOCK)[None, :]
    valid = ((kpos[:, None, :] >= 0) & (kpos[:, None, :] < L)
             & (jnp.abs(qpos[:, :, None] - kpos[:, None, :]) <= WINDOW))
    scale = dh ** -0.5
    s_loc = jnp.einsum('bnqhgd,bnkhd->bnhgqk', qb, kb).astype(jnp.float32) * scale
    s_loc = jnp.where(valid[None, :, None, None], s_loc, NEG_INF)
    s_ctx = jnp.einsum('bnqhgd,bkhd->bnhgqk', qb, kt).astype(jnp.float32) * scale
    s_sink = jnp.broadcast_to(sink.astype(jnp.float32).reshape(1, 1, Hkv, G, 1, 1), s_loc.shape[:-1] + (1,))
    p = jax.nn.softmax(jnp.concatenate([s_loc, s_ctx, s_sink], axis=-1), axis=-1).astype(v.dtype)
    n_loc = 3 * A_BLOCK
    n_ctx = kt.shape[1]
    o = (jnp.einsum('bnhgqk,bnkhd->bnqhgd', p[..., :n_loc], vb)
         + jnp.einsum('bnhgqk,bkhd->bnqhgd', p[..., n_loc:n_loc + n_ctx], vt))
    return o.reshape(B, L, Hkv * G * dh)


def neighbourhood_attention(q, k, v, kt, vt, rpb):
    B, L, H, _, dh = q.shape
    rows = L // GRID_W
    kh = min(NA_KH, rows)
    ncb = GRID_W // NA_QCOLS
    r = jnp.arange(rows)
    key_rows = jnp.clip(r - kh // 2, 0, rows - kh)[:, None] + jnp.arange(kh)[None, :]
    q_cols = jnp.arange(ncb)[:, None] * NA_QCOLS + jnp.arange(NA_QCOLS)[None, :]
    key_cols = (jnp.clip(jnp.arange(ncb) * NA_QCOLS - NA_KW // 2, 0, GRID_W - NA_SLAB)[:, None]
                + jnp.arange(NA_SLAB)[None, :])
    win_start = jnp.clip(q_cols - NA_KW // 2, 0, GRID_W - NA_KW)
    col_in = ((key_cols[:, None, :] >= win_start[:, :, None])
              & (key_cols[:, None, :] < win_start[:, :, None] + NA_KW))
    n_loc = kh * NA_SLAB
    valid = jnp.broadcast_to(col_in[:, :, None, :], (ncb, NA_QCOLS, kh, NA_SLAB)).reshape(ncb, NA_QCOLS, n_loc)
    idx_r = key_rows[:, None, :, None]
    idx_c = key_cols[None, :, None, :]
    k_nb = k.reshape(B, rows, GRID_W, H, dh)[:, idx_r, idx_c].reshape(B, rows, ncb, n_loc, H, dh)
    v_nb = v.reshape(B, rows, GRID_W, H, dh)[:, idx_r, idx_c].reshape(B, rows, ncb, n_loc, H, dh)
    qg = q.reshape(B, rows, ncb, NA_QCOLS, H, dh)
    dr = key_rows - r[:, None] + (NA_KH - 1)
    dc = jnp.clip(key_cols[:, None, :] - q_cols[:, :, None] + (NA_KW - 1), 0, 2 * NA_KW - 2)
    bias = rpb[:, dr[:, None, None, :, None], dc[None, :, :, None, :]]
    bias = jnp.transpose(bias.reshape(H, rows, ncb, NA_QCOLS, n_loc), (1, 2, 0, 3, 4)).astype(jnp.float32)
    scale = dh ** -0.5
    s_loc = jnp.einsum('brcqhd,brckhd->brchqk', qg, k_nb).astype(jnp.float32) * scale + bias[None]
    s_loc = jnp.where(valid[None, None, :, None], s_loc, NEG_INF)
    s_ctx = jnp.einsum('brcqhd,bkhd->brchqk', qg, kt).astype(jnp.float32) * scale
    p = jax.nn.softmax(jnp.concatenate([s_loc, s_ctx], axis=-1), axis=-1).astype(v.dtype)
    o = (jnp.einsum('brchqk,brckhd->brcqhd', p[..., :n_loc], v_nb)
         + jnp.einsum('brchqk,bkhd->brcqhd', p[..., n_loc:], vt))
    return o.reshape(B, L, H * dh)


def global_block_attention(q, k, v, kt, vt):
    B, L, Hkv, G, dh = q.shape
    nb = L // C_BLOCK
    qb = jnp.moveaxis(q.reshape(B, nb, C_BLOCK, Hkv, G, dh), 1, 0)
    k_all = jnp.concatenate([k, kt], axis=1)
    v_all = jnp.concatenate([v, vt], axis=1)
    scale = dh ** -0.5

    def block(q_blk):
        s = jnp.einsum('bqhgd,bkhd->bhgqk', q_blk, k_all).astype(jnp.float32) * scale
        p = jax.nn.softmax(s, axis=-1).astype(v_all.dtype)
        return jnp.einsum('bhgqk,bkhd->bqhgd', p, v_all)

    o = lax.map(block, qb)
    return jnp.moveaxis(o, 0, 1).reshape(B, L, Hkv * G * dh)


def swiglu(h, w_gate, w_up, w_down):
    return (jax.nn.silu(h @ w_gate) * (h @ w_up)) @ w_down


def trunk_layer(x, xt, silu_c, silu_ct, w_mod, b_mod, g_attn, g_ffn, w_in, qk_g, sink, rpb,
                w_out, w_gate, w_up, w_down, cos, sin, update_ctx):
    sh_a, sc_a, ga_a, sh_f, sc_f, ga_f = jnp.split((silu_c @ w_mod + b_mod)[:, None, :], 6, axis=-1)
    tsh_a, tsc_a, tga_a, tsh_f, tsc_f, tga_f = jnp.split(silu_ct @ w_mod + b_mod, 6, axis=-1)
    h = modulate(rms_norm(x, g_attn), sh_a, sc_a)
    ht = modulate(rms_norm(xt, g_attn), tsh_a, tsc_a)
    q_w, k_w, v_w, q_n, k_n, v_n, q_g, k_g, v_g = split_mixer_inputs(h @ w_in, qk_g)
    tq_w, tk_w, tv_w, tq_n, tk_n, tv_n, tq_g, tk_g, tv_g = split_mixer_inputs(ht @ w_in, qk_g)
    q_w, k_w = apply_rope(q_w, cos, sin), apply_rope(k_w, cos, sin)
    q_g, k_g = apply_rope(q_g, cos, sin), apply_rope(k_g, cos, sin)
    o = jnp.concatenate([window_attention(q_w, k_w, v_w, tk_w, tv_w, sink),
                         neighbourhood_attention(q_n, k_n, v_n, tk_n, tv_n, rpb),
                         global_block_attention(q_g, k_g, v_g, tk_g, tv_g)], axis=-1)
    x = x + ga_a * (o @ w_out)
    x = x + ga_f * swiglu(modulate(rms_norm(x, g_ffn), sh_f, sc_f), w_gate, w_up, w_down)
    if update_ctx:
        ot = jnp.concatenate([context_attention(tq_w, tk_w, tv_w, sink),
                              context_attention(tq_n, tk_n, tv_n),
                              context_attention(tq_g, tk_g, tv_g)], axis=-1)
        xt = xt + tga_a * (ot @ w_out)
        xt = xt + tga_f * swiglu(modulate(rms_norm(xt, g_ffn), tsh_f, tsc_f), w_gate, w_up, w_down)
    return x, xt


def setup_inputs(seed: int = 0) -> dict:
    key = jax.random.key(seed)
    ks = jax.random.split(key, 17)
    f32 = jnp.float32

    def nrm(k, shape, s):
        return jax.random.normal(k, shape, f32) * s

    return {
        'x': nrm(ks[0], (BATCH, SEQ, D_MODEL), 1.0),
        'c': nrm(ks[1], (BATCH, D_MODEL), 1.0),
        'ctx': nrm(ks[2], (BATCH, CTX_LEN, D_MODEL), 1.0),
        'c_ctx': nrm(ks[3], (D_MODEL,), 1.0),
        'w_mod': nrm(ks[4], (DEPTH, D_MODEL, 6 * D_MODEL), 0.5 * D_MODEL ** -0.5),
        'b_mod': nrm(ks[5], (DEPTH, 6 * D_MODEL), 0.01),
        'norm_attn': 1.0 + nrm(ks[6], (DEPTH, D_MODEL), 0.01),
        'norm_ffn': 1.0 + nrm(ks[7], (DEPTH, D_MODEL), 0.01),
        'w_in': nrm(ks[8], (DEPTH, D_MODEL, IN_WIDTH), D_MODEL ** -0.5),
        'qk_norm': 1.0 + nrm(ks[9], (DEPTH, 6, HEAD_DIM), 0.01),
        'sink': nrm(ks[10], (DEPTH, A_HEADS), 0.5),
        'rpb': nrm(ks[11], (DEPTH, B_HEADS, 2 * NA_KH - 1, 2 * NA_KW - 1), 0.1),
        'w_out': nrm(ks[12], (DEPTH, MIX_WIDTH, D_MODEL), MIX_WIDTH ** -0.5),
        'w_gate': nrm(ks[13], (DEPTH, D_MODEL, FFN_HIDDEN), D_MODEL ** -0.5),
        'w_up': nrm(ks[14], (DEPTH, D_MODEL, FFN_HIDDEN), D_MODEL ** -0.5),
        'w_down': nrm(ks[15], (DEPTH, FFN_HIDDEN, D_MODEL), FFN_HIDDEN ** -0.5),
    }


def reference(x, c, ctx, c_ctx, w_mod, b_mod, norm_attn, norm_ffn, w_in, qk_norm, sink, rpb,
              w_out, w_gate, w_up, w_down):
    L = x.shape[1]
    cos, sin = axial_rope_tables(L)
    silu_c = jax.nn.silu(c)
    silu_ct = jax.nn.silu(c_ctx)
    xt = ctx
    for i in range(DEPTH):
        x, xt = trunk_layer(x, xt, silu_c, silu_ct, w_mod[i], b_mod[i], norm_attn[i], norm_ffn[i],
                            w_in[i], qk_norm[i], sink[i], rpb[i], w_out[i], w_gate[i], w_up[i], w_down[i],
                            cos, sin, i < DEPTH - 1)
    return x
```

```cpp
#include <hip/hip_runtime.h>
#include <hip/hip_cooperative_groups.h>
#include <cstdio>
namespace cg = cooperative_groups;

#ifndef MULTI_LAUNCH
#define MULTI_LAUNCH 1
#endif

typedef unsigned short u16;
typedef __attribute__((ext_vector_type(8))) short bf16x8;
typedef __attribute__((ext_vector_type(16))) float f32x16;
typedef __attribute__((ext_vector_type(2))) float f32x2;
typedef __attribute__((ext_vector_type(2))) __bf16 bf16x2_t;
#define DI __device__ __forceinline__
#define MFMA32(a, b, c) __builtin_amdgcn_mfma_f32_32x32x16_bf16((a), (b), (c), 0, 0, 0)

constexpr int DM = 1024, NBATCH = 4, SEQL = 4096, CTXL = 256, LTOT = 4352;
constexpr int TLAT = NBATCH * SEQL, TCTX = NBATCH * CTXL, TTOT = TLAT + TCTX;
constexpr int NLAYER = 4, INW = 2048, FFN = 2816, GUW = 2 * FFN;
constexpr float EPSV = 1e-6f;
constexpr float LOG2E = 1.4426950408889634f;

struct Params {
  const float *x, *c, *ctx, *c_ctx, *w_mod, *b_mod, *norm_attn, *norm_ffn, *w_in, *qk_norm, *sink, *rpb,
              *w_out, *w_gate, *w_up, *w_down;
  float* out;
  u16 *wt_in, *wt_out, *wt_gu, *wt_down, *H, *QKV, *O, *ACT;
  float *mod, *xctx, *rope;
  unsigned* counters;
};

DI unsigned pack_bf16(float a, float b) {
  f32x2 v = {a, b};
  bf16x2_t r = __builtin_convertvector(v, bf16x2_t);
  return __builtin_bit_cast(unsigned, r);
}
DI u16 f2bf(float a) { return (u16)(pack_bf16(a, 0.f) & 0xffffu); }
DI int crow(int r, int h) { return (r & 3) + 8 * (r >> 2) + 4 * h; }

DI void wconv_tile(const float* __restrict__ src, int N, int k0, int n0, u16* __restrict__ dst, int K, int rowbase,
                   char* smem) {
  float* tile = (float*)smem;
  const int tid = threadIdx.x;
#pragma unroll
  for (int ps = 0; ps < 4; ++ps) {
    int kk = (tid >> 4) + 16 * ps, nn = (tid & 15) * 4;
    float4 v = *(const float4*)(src + (size_t)(k0 + kk) * N + n0 + nn);
    tile[kk * 65 + nn] = v.x; tile[kk * 65 + nn + 1] = v.y; tile[kk * 65 + nn + 2] = v.z; tile[kk * 65 + nn + 3] = v.w;
  }
  __syncthreads();
  {
    int n = tid >> 2, kc = (tid & 3) * 16;
    unsigned w[8];
#pragma unroll
    for (int j = 0; j < 8; ++j) w[j] = pack_bf16(tile[(kc + 2 * j) * 65 + n], tile[(kc + 2 * j + 1) * 65 + n]);
    uint4* d = (uint4*)(dst + (size_t)(rowbase + n) * K + k0 + kc);
    d[0] = make_uint4(w[0], w[1], w[2], w[3]);
    d[1] = make_uint4(w[4], w[5], w[6], w[7]);
  }
  __syncthreads();
}

DI void phase0(const Params& p, char* smem) {
  const int tid = threadIdx.x;
  constexpr int NW = NLAYER * 2880, NMOD = NLAYER * 96, NROPE = 512;
  for (int item = blockIdx.x; item < NW + NMOD + NROPE; item += gridDim.x) {
    if (item < NW) {
      int layer = item / 2880, idx = item % 2880;
      if (idx < 512) {
        int kt = idx >> 5, nt = idx & 31;
        wconv_tile(p.w_in + (size_t)layer * DM * INW, INW, kt * 64, nt * 64, p.wt_in + (size_t)layer * INW * DM, DM, nt * 64, smem);
      } else if (idx < 768) {
        idx -= 512; int kt = idx >> 4, nt = idx & 15;
        wconv_tile(p.w_out + (size_t)layer * DM * DM, DM, kt * 64, nt * 64, p.wt_out + (size_t)layer * DM * DM, DM, nt * 64, smem);
      } else if (idx < 2176) {
        idx -= 768; int up = idx >= 704; if (up) idx -= 704;
        int kt = idx / 44, nt = idx % 44;
        const float* src = (up ? p.w_up : p.w_gate) + (size_t)layer * DM * FFN;
        float* tile = (float*)smem;
        {
#pragma unroll
          for (int ps = 0; ps < 4; ++ps) {
            int kk = (tid >> 4) + 16 * ps, nn = (tid & 15) * 4;
            float4 v = *(const float4*)(src + (size_t)(kt * 64 + kk) * FFN + nt * 64 + nn);
            tile[kk * 65 + nn] = v.x; tile[kk * 65 + nn + 1] = v.y; tile[kk * 65 + nn + 2] = v.z; tile[kk * 65 + nn + 3] = v.w;
          }
          __syncthreads();
          int n = tid >> 2, kc = (tid & 3) * 16;
          unsigned w[8];
#pragma unroll
          for (int j = 0; j < 8; ++j) w[j] = pack_bf16(tile[(kc + 2 * j) * 65 + n], tile[(kc + 2 * j + 1) * 65 + n]);
          int row = nt * 128 + (n >> 5) * 64 + (n & 31) + (up ? 32 : 0);
          uint4* d = (uint4*)(p.wt_gu + (size_t)layer * GUW * DM + (size_t)row * DM + kt * 64 + kc);
          d[0] = make_uint4(w[0], w[1], w[2], w[3]);
          d[1] = make_uint4(w[4], w[5], w[6], w[7]);
          __syncthreads();
        }
      } else {
        idx -= 2176; int kt = idx >> 4, nt = idx & 15;
        wconv_tile(p.w_down + (size_t)layer * FFN * DM, DM, kt * 64, nt * 64, p.wt_down + (size_t)layer * DM * FFN, FFN, nt * 64, smem);
      }
    } else if (item < NW + NMOD) {
      int it = item - NW, layer = it / 96, cg0 = (it % 96) * 64;
      float* sc = (float*)smem;
      float* red = sc + 5 * 1024;
      for (int e = tid; e < 5 * 1024; e += 256) {
        int mb = e >> 10, k = e & 1023;
        float v = (mb < 4) ? p.c[mb * 1024 + k] : p.c_ctx[k];
        sc[e] = v / (1.f + __expf(-v));
      }
      __syncthreads();
      int col = cg0 + (tid & 63), kq = tid >> 6;
      const float* w = p.w_mod + (size_t)layer * DM * 6144 + col;
      float a0 = 0, a1 = 0, a2 = 0, a3 = 0, a4 = 0;
#pragma unroll 8
      for (int k = kq * 256; k < kq * 256 + 256; ++k) {
        float wv = w[(size_t)k * 6144];
        a0 += sc[k] * wv; a1 += sc[1024 + k] * wv; a2 += sc[2048 + k] * wv; a3 += sc[3072 + k] * wv; a4 += sc[4096 + k] * wv;
      }
      int c64 = tid & 63;
      red[(kq * 5 + 0) * 64 + c64] = a0; red[(kq * 5 + 1) * 64 + c64] = a1; red[(kq * 5 + 2) * 64 + c64] = a2;
      red[(kq * 5 + 3) * 64 + c64] = a3; red[(kq * 5 + 4) * 64 + c64] = a4;
      __syncthreads();
      for (int e = tid; e < 5 * 64; e += 256) {
        int mb = e >> 6, cc = e & 63;
        float s = red[(0 * 5 + mb) * 64 + cc] + red[(1 * 5 + mb) * 64 + cc] + red[(2 * 5 + mb) * 64 + cc] + red[(3 * 5 + mb) * 64 + cc];
        p.mod[((size_t)layer * 5 + mb) * 6144 + cg0 + cc] = s + p.b_mod[layer * 6144 + cg0 + cc];
      }
      __syncthreads();
    } else {
      int e = (item - NW - NMOD) * 256 + tid;
      int t = e >> 5, pi = e & 31;
      float pos = (pi < 16) ? (float)(t >> 6) : (float)(t & 63);
      float inv = exp2f(-(float)(pi & 15) * (13.287712379549449f / 16.0f));
      float ang = pos * inv;
      p.rope[2 * e] = __cosf(ang);
      p.rope[2 * e + 1] = __sinf(ang);
    }
  }
}

DI const float* xrow_src(const Params& p, int layer, int t) {
  if (t < TLAT) return (layer == 0 ? p.x : p.out) + (size_t)t * DM;
  return (layer == 0 ? p.ctx : p.xctx) + (size_t)(t - TLAT) * DM;
}
DI float* xrow_dst(const Params& p, int t) {
  if (t < TLAT) return p.out + (size_t)t * DM;
  return p.xctx + (size_t)(t - TLAT) * DM;
}
DI int mb_of(int t) { return t < TLAT ? (t >> 12) : 4; }

DI void phase_norm(const Params& p, int layer, int which, int nrows) {
  const int lane = threadIdx.x & 63, wid = threadIdx.x >> 6;
  const float* g = (which ? p.norm_ffn : p.norm_attn) + layer * DM;
  for (int t = blockIdx.x * 4 + wid; t < nrows; t += gridDim.x * 4) {
    const float* xr = which ? (const float*)xrow_dst(p, t) : xrow_src(p, layer, t);
    const float* md = p.mod + ((size_t)layer * 5 + mb_of(t)) * 6144 + (which ? 3 * 1024 : 0);
    float4 v[4];
    float ss = 0.f;
#pragma unroll
    for (int j = 0; j < 4; ++j) {
      v[j] = *(const float4*)(xr + lane * 4 + 256 * j);
      ss += v[j].x * v[j].x + v[j].y * v[j].y + v[j].z * v[j].z + v[j].w * v[j].w;
    }
#pragma unroll
    for (int o = 32; o >= 1; o >>= 1) ss += __shfl_xor(ss, o);
    float r = rsqrtf(ss * (1.f / 1024.f) + EPSV);
#pragma unroll
    for (int j = 0; j < 4; ++j) {
      int col = lane * 4 + 256 * j;
      float4 gg = *(const float4*)(g + col);
      float4 sh = *(const float4*)(md + col);
      float4 sc = *(const float4*)(md + 1024 + col);
      float o0 = v[j].x * r * gg.x * (1.f + sc.x) + sh.x;
      float o1 = v[j].y * r * gg.y * (1.f + sc.y) + sh.y;
      float o2 = v[j].z * r * gg.z * (1.f + sc.z) + sh.z;
      float o3 = v[j].w * r * gg.w * (1.f + sc.w) + sh.w;
      *(uint2*)(p.H + (size_t)t * DM + col) = make_uint2(pack_bf16(o0, o1), pack_bf16(o2, o3));
    }
  }
}

constexpr int LROW = 144;
constexpr int TILE_B = 128 * LROW;
constexpr int GEMM_LDS = 4 * TILE_B;
enum { EPI_QKV = 0, EPI_RES = 1, EPI_GU = 2 };

template <int EPI>
DI void gemm_tile(const Params& p, int layer, const u16* __restrict__ A, const u16* __restrict__ Bt, int K, int mt, int nt,
                  int gidx, char* smem) {
  const int tid = threadIdx.x, lane = tid & 63, wid = tid >> 6, wm = wid >> 1, wn = wid & 1;
  const int l32 = lane & 31, h = lane >> 5;
  const int m0 = mt * 128, n0 = nt * 128;
  const int lr = tid >> 3, lc = tid & 7;
  const u16* ga = A + (size_t)(m0 + lr) * K + lc * 8;
  const u16* gb = Bt + (size_t)(n0 + lr) * K + lc * 8;
  uint4 ra[4], rb[4];
  f32x16 acc[2][2];
#pragma unroll
  for (int i = 0; i < 2; ++i)
#pragma unroll
    for (int j = 0; j < 2; ++j)
#pragma unroll
      for (int r = 0; r < 16; ++r) acc[i][j][r] = 0.f;

#define GLOAD(k0)                                                             \
  _Pragma("unroll") for (int ps = 0; ps < 4; ++ps) {                          \
    ra[ps] = *(const uint4*)(ga + (size_t)ps * 32 * K + (k0));                \
    rb[ps] = *(const uint4*)(gb + (size_t)ps * 32 * K + (k0));                \
  }
#define SWRITE(buf)                                                                           \
  _Pragma("unroll") for (int ps = 0; ps < 4; ++ps) {                                          \
    *(uint4*)(smem + (buf) * 2 * TILE_B + (lr + 32 * ps) * LROW + lc * 16) = ra[ps];          \
    *(uint4*)(smem + (buf) * 2 * TILE_B + TILE_B + (lr + 32 * ps) * LROW + lc * 16) = rb[ps]; \
  }

  const int nk = K >> 6;
  GLOAD(0);
  SWRITE(0);
  __syncthreads();
  for (int kt = 0; kt < nk; ++kt) {
    if (kt + 1 < nk) { GLOAD((kt + 1) * 64); }
    const char* a_s = smem + (kt & 1) * 2 * TILE_B + (wm * 64 + l32) * LROW + h * 16;
    const char* b_s = smem + (kt & 1) * 2 * TILE_B + TILE_B + (wn * 64 + l32) * LROW + h * 16;
#pragma unroll
    for (int s = 0; s < 4; ++s) {
      bf16x8 a0 = *(const bf16x8*)(a_s + s * 32);
      bf16x8 a1 = *(const bf16x8*)(a_s + 32 * LROW + s * 32);
      bf16x8 b0 = *(const bf16x8*)(b_s + s * 32);
      bf16x8 b1 = *(const bf16x8*)(b_s + 32 * LROW + s * 32);
      if (EPI == EPI_QKV) {
        acc[0][0] = MFMA32(b0, a0, acc[0][0]); acc[0][1] = MFMA32(b1, a0, acc[0][1]);
        acc[1][0] = MFMA32(b0, a1, acc[1][0]); acc[1][1] = MFMA32(b1, a1, acc[1][1]);
      } else {
        acc[0][0] = MFMA32(a0, b0, acc[0][0]); acc[0][1] = MFMA32(a0, b1, acc[0][1]);
        acc[1][0] = MFMA32(a1, b0, acc[1][0]); acc[1][1] = MFMA32(a1, b1, acc[1][1]);
      }
    }
    if (kt + 1 < nk) { SWRITE((kt + 1) & 1); }
    __syncthreads();
  }
#undef GLOAD
#undef SWRITE

  if (EPI == EPI_QKV) {
    const int chunk = nt * 2 + wn;
    const bool isV = (chunk == 8 || chunk == 9 || (chunk >= 18 && chunk <= 21) || chunk >= 30);
    int gi = 0;
    if (chunk < 6) gi = 0; else if (chunk < 8) gi = 1; else if (chunk < 14) gi = 2; else if (chunk < 18) gi = 3;
    else if (chunk < 28) gi = 4; else gi = 5;
    const bool ropeT = (gi == 0 || gi == 1 || gi == 4 || gi == 5);
    const float* gam = p.qk_norm + (layer * 6 + gi) * 64;
#pragma unroll
    for (int i = 0; i < 2; ++i) {
      int t = m0 + wm * 64 + i * 32 + l32;
      int b, pos; bool isctx = t >= TLAT;
      if (!isctx) { b = t >> 12; pos = t & 4095; } else { b = (t - TLAT) >> 8; pos = 4096 + ((t - TLAT) & 255); }
      u16* base = p.QKV + (size_t)(b * 32 + chunk) * LTOT * 64;
      if (isV) {
#pragma unroll
        for (int j = 0; j < 2; ++j)
#pragma unroll
          for (int r = 0; r < 16; ++r) {
            int d = j * 32 + crow(r, h);
            base[(size_t)d * LTOT + pos] = f2bf(acc[i][j][r]);
          }
      } else {
        float ss = 0.f;
#pragma unroll
        for (int j = 0; j < 2; ++j)
#pragma unroll
          for (int r = 0; r < 16; ++r) ss += acc[i][j][r] * acc[i][j][r];
        ss += __shfl_xor(ss, 32);
        float rinv = rsqrtf(ss * (1.f / 64.f) + EPSV);
        const bool doRope = ropeT && !isctx;
        const float* rp = p.rope + (size_t)(isctx ? 0 : pos) * 64;
        u16* dst = base + (size_t)pos * 64;
#pragma unroll
        for (int g = 0; g < 4; ++g) {
          float o1[4], o2[4];
#pragma unroll
          for (int q = 0; q < 4; ++q) {
            int r = g * 4 + q, d = crow(r, h);
            float x1 = acc[i][0][r] * rinv * gam[d];
            float x2 = acc[i][1][r] * rinv * gam[d + 32];
            if (doRope) {
              float cs = rp[2 * d], sn = rp[2 * d + 1];
              o1[q] = x1 * cs - x2 * sn;
              o2[q] = x2 * cs + x1 * sn;
            } else { o1[q] = x1; o2[q] = x2; }
          }
          int d0 = 8 * g + 4 * h;
          *(uint2*)(dst + d0) = make_uint2(pack_bf16(o1[0], o1[1]), pack_bf16(o1[2], o1[3]));
          *(uint2*)(dst + 32 + d0) = make_uint2(pack_bf16(o2[0], o2[1]), pack_bf16(o2[2], o2[3]));
        }
      }
    }
  } else if (EPI == EPI_RES) {
    const int mb = mb_of(m0);
    const float* gate = p.mod + ((size_t)layer * 5 + mb) * 6144 + gidx * 1024;
#pragma unroll
    for (int j = 0; j < 2; ++j) {
      int n = n0 + wn * 64 + j * 32 + l32;
      float gv = gate[n];
#pragma unroll
      for (int i = 0; i < 2; ++i)
#pragma unroll
        for (int r = 0; r < 16; ++r) {
          int t = m0 + wm * 64 + i * 32 + crow(r, h);
          const float* src = (gidx == 2) ? xrow_src(p, layer, t) : (const float*)xrow_dst(p, t);
          float* dst = xrow_dst(p, t);
          dst[n] = src[n] + gv * acc[i][j][r];
        }
    }
  } else {
    int col = nt * 64 + wn * 32 + l32;
#pragma unroll
    for (int i = 0; i < 2; ++i)
#pragma unroll
      for (int r = 0; r < 16; ++r) {
        int t = m0 + wm * 64 + i * 32 + crow(r, h);
        float gte = acc[i][0][r], up = acc[i][1][r];
        float a = gte / (1.f + __expf(-gte)) * up;
        p.ACT[(size_t)t * FFN + col] = f2bf(a);
      }
  }
}

constexpr int KROW = 144, VROW = 136;
constexpr int KT_B = 64 * KROW, VT_B = 64 * VROW, KV_B = KT_B + VT_B;
constexpr int RPB_OFF = 2 * KV_B;

DI void attn_item(const Params& p, int layer, int item, char* smem) {
  const int tid = threadIdx.x, lane = tid & 63, wid = tid >> 6, l32 = lane & 31, h = lane >> 5;
  int mode, b, hh, qb;
  if (item < 768) { mode = 0; b = item / 192; int rem = item % 192; hh = rem >> 5; qb = rem & 31; }
  else if (item < 1280) { int it = item - 768; mode = 1; b = it >> 7; hh = (it & 127) >> 5; qb = it & 31; }
  else if (item < 2048) { int it = item - 1280; mode = 2; b = it / 192; int rem = it % 192; hh = rem >> 5; qb = rem & 31; }
  else { int it = item - 2048; mode = 3; b = it >> 5; hh = (it & 31) >> 1; qb = it & 1; }

  int qchunk, kchunk, vchunk, head16, t0 = 0, t1 = 0, qpos0 = qb * 128;
  bool hasSink = false; float sinkv = 0.f;
  int maskmode = 0;
  if (mode == 0) { qchunk = 22 + hh; kchunk = 28 + hh / 3; vchunk = 30 + hh / 3; head16 = 10 + hh; t0 = 0; t1 = 64; }
  else if (mode == 1) {
    qchunk = 10 + hh; kchunk = 14 + hh; vchunk = 18 + hh; head16 = 6 + hh; maskmode = 1;
    t0 = min(max(2 * qb - 4, 0), 56); t1 = min(max(2 * qb + 1 - 4, 0), 56) + 8;
  } else if (mode == 2) {
    qchunk = hh; kchunk = 6 + hh / 3; vchunk = 8 + hh / 3; head16 = hh; maskmode = 2;
    t0 = max(0, 2 * (qb - 1)); t1 = min(64, 2 * (qb + 2)); hasSink = true; sinkv = p.sink[layer * 6 + hh];
  } else {
    head16 = hh; qpos0 = 4096 + qb * 128;
    if (hh < 6) { qchunk = hh; kchunk = 6 + hh / 3; vchunk = 8 + hh / 3; hasSink = true; sinkv = p.sink[layer * 6 + hh]; }
    else if (hh < 10) { int hb = hh - 6; qchunk = 10 + hb; kchunk = 14 + hb; vchunk = 18 + hb; }
    else { int hc = hh - 10; qchunk = 22 + hc; kchunk = 28 + hc / 3; vchunk = 30 + hc / 3; }
  }
  const int n_it = 4 + (t1 - t0);
  const u16* Qb = p.QKV + (size_t)(b * 32 + qchunk) * LTOT * 64;
  const u16* Kb = p.QKV + (size_t)(b * 32 + kchunk) * LTOT * 64;
  const u16* Vb = p.QKV + (size_t)(b * 32 + vchunk) * LTOT * 64;
  float* s_rpb = (float*)(smem + RPB_OFF);
  if (mode == 1) {
    const float* rp = p.rpb + (size_t)(layer * 4 + hh) * 465;
    for (int e = tid; e < 465; e += 256) s_rpb[e] = rp[e] * LOG2E;
  }

  const int qpos = qpos0 + wid * 32 + l32;
  bf16x8 qf[4];
#pragma unroll
  for (int s = 0; s < 4; ++s) qf[s] = *(const bf16x8*)(Qb + (size_t)qpos * 64 + s * 16 + h * 8);

  f32x16 o0, o1;
#pragma unroll
  for (int r = 0; r < 16; ++r) { o0[r] = 0.f; o1[r] = 0.f; }
  float m_run = -INFINITY, l_run = 0.f;

  const int lr = tid >> 3, lc = tid & 7;
  uint4 kr0, kr1, vr0, vr1;
#define TILE_OF(it) ((it) < 4 ? 64 + (it) : t0 + (it) - 4)
#define AGLOAD(tile)                                                                   \
  {                                                                                    \
    kr0 = *(const uint4*)(Kb + (size_t)((tile) * 64 + lr) * 64 + lc * 8);              \
    kr1 = *(const uint4*)(Kb + (size_t)((tile) * 64 + lr + 32) * 64 + lc * 8);         \
    vr0 = *(const uint4*)(Vb + (size_t)(lr) * LTOT + (tile) * 64 + lc * 8);            \
    vr1 = *(const uint4*)(Vb + (size_t)(lr + 32) * LTOT + (tile) * 64 + lc * 8);       \
  }
#define ASWRITE(buf)                                                                   \
  {                                                                                    \
    *(uint4*)(smem + (buf) * KV_B + (lr) * KROW + lc * 16) = kr0;                      \
    *(uint4*)(smem + (buf) * KV_B + (lr + 32) * KROW + lc * 16) = kr1;                 \
    char* vd = smem + (buf) * KV_B + KT_B + (lr) * VROW + lc * 16;                     \
    *(uint2*)(vd) = make_uint2(vr0.x, vr0.y);                                          \
    *(uint2*)(vd + 8) = make_uint2(vr0.z, vr0.w);                                      \
    *(uint2*)(vd + 32 * VROW) = make_uint2(vr1.x, vr1.y);                              \
    *(uint2*)(vd + 32 * VROW + 8) = make_uint2(vr1.z, vr1.w);                          \
  }

  AGLOAD(TILE_OF(0));
  ASWRITE(0);
  __syncthreads();
  const float sc2 = 0.125f * LOG2E;
  const int tq = qb * 128 + wid * 32 + l32;
  for (int it = 0; it < n_it; ++it) {
    const int tile = TILE_OF(it);
    if (it + 1 < n_it) { int tn = TILE_OF(it + 1); AGLOAD(tn); }
    bool skip = false;
    if (tile < 64) {
      if (maskmode == 1) {
        int qr = (qb * 128 + wid * 32) >> 6;
        int kr0 = min(max(qr - 4, 0), 56);
        skip = (tile < kr0) || (tile >= kr0 + 8);
      } else if (maskmode == 2) {
        int q0w = qb * 128 + wid * 32, tk0 = tile * 64;
        skip = (tk0 > q0w + 31 + 128) || (tk0 + 63 < q0w - 128);
      }
    }
    if (!skip) {
      const char* sK = smem + (it & 1) * KV_B;
      const char* sV = sK + KT_B;
      f32x16 S[2];
#pragma unroll
      for (int kt = 0; kt < 2; ++kt) {
#pragma unroll
        for (int r = 0; r < 16; ++r) S[kt][r] = 0.f;
#pragma unroll
        for (int s = 0; s < 4; ++s) {
          bf16x8 kf = *(const bf16x8*)(sK + (kt * 32 + l32) * KROW + s * 32 + h * 16);
          S[kt] = MFMA32(kf, qf[s], S[kt]);
        }
      }
      if (tile < 64 && maskmode == 1) {
        int qr = tq >> 6, qc = tq & 63;
        int ws = min(max(qc - 8, 0), 48);
        int dr = tile - qr + 7;
#pragma unroll
        for (int kt = 0; kt < 2; ++kt)
#pragma unroll
          for (int r = 0; r < 16; ++r) {
            int kc = kt * 32 + crow(r, h);
            bool ok = (unsigned)(kc - ws) < 16u;
            int bi = ok ? (dr * 31 + kc - qc + 15) : 0;
            float bv = s_rpb[bi];
            S[kt][r] = ok ? (S[kt][r] * sc2 + bv) : -INFINITY;
          }
      } else if (tile < 64 && maskmode == 2) {
#pragma unroll
        for (int kt = 0; kt < 2; ++kt)
#pragma unroll
          for (int r = 0; r < 16; ++r) {
            int tk = tile * 64 + kt * 32 + crow(r, h);
            int dd = tq - tk;
            bool ok = (dd <= 128) && (dd >= -128);
            S[kt][r] = ok ? S[kt][r] * sc2 : -INFINITY;
          }
      } else {
#pragma unroll
        for (int kt = 0; kt < 2; ++kt)
#pragma unroll
          for (int r = 0; r < 16; ++r) S[kt][r] *= sc2;
      }
      float mx = S[0][0];
#pragma unroll
      for (int kt = 0; kt < 2; ++kt)
#pragma unroll
        for (int r = 0; r < 16; ++r) mx = fmaxf(mx, S[kt][r]);
      mx = fmaxf(mx, __shfl_xor(mx, 32));
      float m_new = fmaxf(m_run, mx);
      float alpha = __builtin_amdgcn_exp2f(m_run - m_new);
      m_run = m_new;
      float ls = 0.f;
#pragma unroll
      for (int kt = 0; kt < 2; ++kt)
#pragma unroll
        for (int r = 0; r < 16; ++r) {
          float pv = __builtin_amdgcn_exp2f(S[kt][r] - m_new);
          S[kt][r] = pv;
          ls += pv;
        }
      l_run = l_run * alpha + ls;
#pragma unroll
      for (int r = 0; r < 16; ++r) { o0[r] *= alpha; o1[r] *= alpha; }
#pragma unroll
      for (int kt = 0; kt < 2; ++kt)
#pragma unroll
        for (int s2 = 0; s2 < 2; ++s2) {
          uint4 pw;
          pw.x = pack_bf16(S[kt][8 * s2 + 0], S[kt][8 * s2 + 1]);
          pw.y = pack_bf16(S[kt][8 * s2 + 2], S[kt][8 * s2 + 3]);
          pw.z = pack_bf16(S[kt][8 * s2 + 4], S[kt][8 * s2 + 5]);
          pw.w = pack_bf16(S[kt][8 * s2 + 6], S[kt][8 * s2 + 7]);
          bf16x8 pf = __builtin_bit_cast(bf16x8, pw);
          int koff = (kt * 32 + 16 * s2 + 4 * h) * 2;
          {
            uint2 va = *(const uint2*)(sV + l32 * VROW + koff);
            uint2 vb = *(const uint2*)(sV + l32 * VROW + koff + 16);
            bf16x8 vf = __builtin_bit_cast(bf16x8, make_uint4(va.x, va.y, vb.x, vb.y));
            o0 = MFMA32(vf, pf, o0);
          }
          {
            uint2 va = *(const uint2*)(sV + (32 + l32) * VROW + koff);
            uint2 vb = *(const uint2*)(sV + (32 + l32) * VROW + koff + 16);
            bf16x8 vf = __builtin_bit_cast(bf16x8, make_uint4(va.x, va.y, vb.x, vb.y));
            o1 = MFMA32(vf, pf, o1);
          }
        }
    }
    if (it + 1 < n_it) { ASWRITE((it + 1) & 1); }
    __syncthreads();
  }
#undef AGLOAD
#undef ASWRITE
#undef TILE_OF

  float l_tot = l_run + __shfl_xor(l_run, 32);
  if (hasSink) l_tot += __builtin_amdgcn_exp2f(sinkv * LOG2E - m_run);
  float inv = 1.f / l_tot;
  int T = (mode == 3) ? (TLAT + b * 256 + (qpos - 4096)) : (b * 4096 + qpos);
  u16* od = p.O + (size_t)T * DM + head16 * 64;
#pragma unroll
  for (int g = 0; g < 4; ++g) {
    int d0 = 8 * g + 4 * h;
    *(uint2*)(od + d0) = make_uint2(pack_bf16(o0[4 * g] * inv, o0[4 * g + 1] * inv), pack_bf16(o0[4 * g + 2] * inv, o0[4 * g + 3] * inv));
    *(uint2*)(od + 32 + d0) = make_uint2(pack_bf16(o1[4 * g] * inv, o1[4 * g + 1] * inv), pack_bf16(o1[4 * g + 2] * inv, o1[4 * g + 3] * inv));
  }
}

DI void phase_attn(const Params& p, int layer, char* smem) {
  __shared__ int s_item;
  const int nitems = 2048 + (layer < NLAYER - 1 ? 128 : 0);
  while (true) {
    if (threadIdx.x == 0) s_item = (int)atomicAdd(&p.counters[layer], 1u);
    __syncthreads();
    int item = s_item;
    __syncthreads();
    if (item >= nitems) break;
    attn_item(p, layer, item, smem);
  }
}

DI void run_phase(const Params& p, int ph, int layer, char* smem) {
  const bool last = (layer == NLAYER - 1);
  const int mtiles_all = TTOT / 128;
  const int mtiles_upd = last ? TLAT / 128 : mtiles_all;
  switch (ph) {
    case 0: phase0(p, smem); break;
    case 1: phase_norm(p, layer, 0, TTOT); break;
    case 2:
      for (int i = blockIdx.x; i < mtiles_all * 16; i += gridDim.x)
        gemm_tile<EPI_QKV>(p, layer, p.H, p.wt_in + (size_t)layer * INW * DM, DM, i >> 4, i & 15, 0, smem);
      break;
    case 3: phase_attn(p, layer, smem); break;
    case 4:
      for (int i = blockIdx.x; i < mtiles_upd * 8; i += gridDim.x)
        gemm_tile<EPI_RES>(p, layer, p.O, p.wt_out + (size_t)layer * DM * DM, DM, i >> 3, i & 7, 2, smem);
      break;
    case 5: phase_norm(p, layer, 1, last ? TLAT : TTOT); break;
    case 6:
      for (int i = blockIdx.x; i < mtiles_upd * 44; i += gridDim.x)
        gemm_tile<EPI_GU>(p, layer, p.H, p.wt_gu + (size_t)layer * GUW * DM, DM, i / 44, i % 44, 0, smem);
      break;
    case 7:
      for (int i = blockIdx.x; i < mtiles_upd * 8; i += gridDim.x)
        gemm_tile<EPI_RES>(p, layer, p.ACT, p.wt_down + (size_t)layer * DM * FFN, FFN, i >> 3, i & 7, 5, smem);
      break;
  }
}

#if !MULTI_LAUNCH
__global__ void __launch_bounds__(256, 2) fwd_megakernel(Params p) {
  __shared__ __attribute__((aligned(16))) char smem[GEMM_LDS];
  cg::grid_group grid = cg::this_grid();
  run_phase(p, 0, 0, smem);
  grid.sync();
  for (int layer = 0; layer < NLAYER; ++layer) {
    for (int ph = 1; ph <= 7; ++ph) {
      run_phase(p, ph, layer, smem);
      if (!(layer == NLAYER - 1 && ph == 7)) grid.sync();
    }
  }
}

#else
__global__ void __launch_bounds__(256, 2) phase_kernel(Params p, int ph, int layer) {
  __shared__ __attribute__((aligned(16))) char smem[GEMM_LDS];
  run_phase(p, ph, layer, smem);
}
#endif

extern "C" void kernel_launch(void* const* d_in, const int* in_sizes, int n_in, void* d_out, int out_size, void* d_ws,
                              size_t ws_size, hipStream_t stream) {
  Params p{};
  p.x = (const float*)d_in[0]; p.c = (const float*)d_in[1]; p.ctx = (const float*)d_in[2]; p.c_ctx = (const float*)d_in[3];
  p.w_mod = (const float*)d_in[4]; p.b_mod = (const float*)d_in[5]; p.norm_attn = (const float*)d_in[6];
  p.norm_ffn = (const float*)d_in[7]; p.w_in = (const float*)d_in[8]; p.qk_norm = (const float*)d_in[9];
  p.sink = (const float*)d_in[10]; p.rpb = (const float*)d_in[11]; p.w_out = (const float*)d_in[12];
  p.w_gate = (const float*)d_in[13]; p.w_up = (const float*)d_in[14]; p.w_down = (const float*)d_in[15];
  p.out = (float*)d_out;
  char* w = (char*)d_ws;
  size_t off = 0;
  auto take = [&](size_t bytes) { char* r = w + off; off += (bytes + 255) & ~(size_t)255; return r; };
  p.counters = (unsigned*)take(256);
  p.wt_in = (u16*)take((size_t)NLAYER * INW * DM * 2);
  p.wt_out = (u16*)take((size_t)NLAYER * DM * DM * 2);
  p.wt_gu = (u16*)take((size_t)NLAYER * GUW * DM * 2);
  p.wt_down = (u16*)take((size_t)NLAYER * DM * FFN * 2);
  p.H = (u16*)take((size_t)TTOT * DM * 2);
  p.mod = (float*)take((size_t)NLAYER * 5 * 6144 * 4);
  p.xctx = (float*)take((size_t)TCTX * DM * 4);
  p.rope = (float*)take((size_t)SEQL * 32 * 2 * 4);
  p.QKV = (u16*)take((size_t)NBATCH * 32 * LTOT * 64 * 2);
  p.O = (u16*)take((size_t)TTOT * DM * 2);
  p.ACT = p.QKV;

  hipMemsetAsync(p.counters, 0, 256, stream);

  static int grid_blocks = 0;
  if (!grid_blocks) {
    int dev = 0, cus = 0, per_cu = 0;
    hipGetDevice(&dev);
    hipDeviceGetAttribute(&cus, hipDeviceAttributeMultiprocessorCount, dev);
#if MULTI_LAUNCH
    hipOccupancyMaxActiveBlocksPerMultiprocessor(&per_cu, phase_kernel, 256, 0);
#else
    hipOccupancyMaxActiveBlocksPerMultiprocessor(&per_cu, fwd_megakernel, 256, 0);
#endif
    if (per_cu > 2) per_cu = 2;
    if (per_cu < 1) per_cu = 1;
    grid_blocks = cus * per_cu;
  }
#if MULTI_LAUNCH
  phase_kernel<<<grid_blocks, 256, 0, stream>>>(p, 0, 0);
  for (int layer = 0; layer < NLAYER; ++layer)
    for (int ph = 1; ph <= 7; ++ph) phase_kernel<<<grid_blocks, 256, 0, stream>>>(p, ph, layer);
#else
  void* args[] = {&p};
  hipError_t e = hipLaunchCooperativeKernel((void*)fwd_megakernel, dim3(grid_blocks), dim3(256), args, 0, stream);
  if (e != hipSuccess) fprintf(stderr, "cooperative launch failed: %s (grid %d)\n", hipGetErrorString(e), grid_blocks);
#endif
}
```

```cpp
#include <hip/hip_runtime.h>
#include <hip/hip_cooperative_groups.h>
#include <cstdio>
namespace cg = cooperative_groups;

typedef unsigned short u16;
typedef __attribute__((ext_vector_type(8))) short bf16x8;
typedef __attribute__((ext_vector_type(16))) float f32x16;
typedef __attribute__((ext_vector_type(4))) float f32x4;
typedef __attribute__((ext_vector_type(2))) float f32x2;
typedef __attribute__((ext_vector_type(2))) __bf16 bf16x2_t;
#define DI __device__ __forceinline__
#define LAS __attribute__((address_space(3)))
#define MFMA32(a, b, c) __builtin_amdgcn_mfma_f32_32x32x16_bf16((a), (b), (c), 0, 0, 0)

constexpr int DM = 1024, NBATCH = 4, SEQL = 4096, CTXL = 256, LTOT = 4352;
constexpr int TLAT = NBATCH * SEQL, TCTX = NBATCH * CTXL, TTOT = TLAT + TCTX;
constexpr int NLAYER = 4, INW = 2048, FFN = 2816, GUW = 2 * FFN;
constexpr int LDK = DM, LDF = FFN;
constexpr int NTHR = 512;
constexpr int DYN_LDS = 131072 + 64;
constexpr float EPSV = 1e-6f;
constexpr float LOG2E = 1.4426950408889634f;

struct Params {
  const float *x, *c, *ctx, *c_ctx, *w_mod, *b_mod, *norm_attn, *norm_ffn, *w_in, *qk_norm, *sink, *rpb,
              *w_out, *w_gate, *w_up, *w_down;
  float* out;
  u16 *wt_in, *wt_out, *wt_gu, *wt_down, *H, *QKV, *O, *ACT;
  float *mod, *xctx, *rope, *bounds;
  unsigned* counters;
};

DI unsigned pack_bf16(float a, float b) {
  f32x2 v = {a, b};
  bf16x2_t r = __builtin_convertvector(v, bf16x2_t);
  return __builtin_bit_cast(unsigned, r);
}
DI u16 f2bf(float a) { return (u16)(pack_bf16(a, 0.f) & 0xffffu); }
DI int tidx() { int t = threadIdx.x; asm volatile("" : "+v"(t)); return t; }
DI int crow(int r, int h) { return (r & 3) + 8 * (r >> 2) + 4 * h; }

DI int grab(unsigned* ctr) {
  __shared__ int s_grab;
  if (threadIdx.x == 0) s_grab = (int)atomicAdd(ctr, 1u);
  __syncthreads();
  int v = s_grab;
  __syncthreads();
  return v;
}

DI void phase0(const Params& p, char* smem) {
  const int tid = tidx();
  constexpr int NWP = NLAYER * 2880 / 2, NMOD = NLAYER * 96, NROPE = 256, NBND = 1;
  const float* w_in_ = p.w_in; const float* w_out_ = p.w_out; const float* w_gate_ = p.w_gate;
  const float* w_up_ = p.w_up; const float* w_down_ = p.w_down;
  asm volatile("" : "+v"(w_in_), "+v"(w_out_), "+v"(w_gate_), "+v"(w_up_), "+v"(w_down_));
  for (int item = blockIdx.x; item < NWP + NMOD + NROPE + NBND; item += gridDim.x) {
    if (item < NWP) {
      const int half = tid >> 8, t = tid & 255;
      const int it2 = item * 2 + half;
      const int layer = it2 / 2880; int idx = it2 % 2880;
      const float* src; int N, k0, n0, Kd, up = 0, kind;
      u16* dst;
      if (idx < 512) { kind = 0; k0 = (idx >> 5) * 64; n0 = (idx & 31) * 64; src = w_in_ + (size_t)layer * DM * INW; N = INW; dst = p.wt_in + (size_t)layer * INW * DM; Kd = DM; }
      else if (idx < 768) { idx -= 512; kind = 0; k0 = (idx >> 4) * 64; n0 = (idx & 15) * 64; src = w_out_ + (size_t)layer * DM * DM; N = DM; dst = p.wt_out + (size_t)layer * DM * DM; Kd = DM; }
      else if (idx < 2176) { idx -= 768; up = idx >= 704; if (up) idx -= 704; kind = 1; k0 = (idx / 44) * 64; n0 = (idx % 44) * 64;
        src = (up ? w_up_ : w_gate_) + (size_t)layer * DM * FFN; N = FFN; dst = p.wt_gu + (size_t)layer * GUW * DM; Kd = DM; }
      else { idx -= 2176; kind = 0; k0 = (idx >> 4) * 64; n0 = (idx & 15) * 64; src = w_down_ + (size_t)layer * FFN * DM; N = DM; dst = p.wt_down + (size_t)layer * DM * FFN; Kd = FFN; }
      float* tile = (float*)(smem + half * 16640);
#pragma unroll
      for (int ps = 0; ps < 4; ++ps) {
        int kk = (t >> 4) + 16 * ps, nn = (t & 15) * 4;
        float4 v = *(const float4*)(src + (size_t)(k0 + kk) * N + n0 + nn);
        tile[kk * 65 + nn] = v.x; tile[kk * 65 + nn + 1] = v.y; tile[kk * 65 + nn + 2] = v.z; tile[kk * 65 + nn + 3] = v.w;
      }
      __syncthreads();
      {
        int n = t >> 2, kc = (t & 3) * 16;
        unsigned w[8];
#pragma unroll
        for (int j = 0; j < 8; ++j) w[j] = pack_bf16(tile[(kc + 2 * j) * 65 + n], tile[(kc + 2 * j + 1) * 65 + n]);
        int col = n0 + n;
        int row = kind ? ((col >> 7) * 256 + up * 128 + (col & 127)) : col;
        uint4* d = (uint4*)(dst + (size_t)row * Kd + k0 + kc);
        d[0] = make_uint4(w[0], w[1], w[2], w[3]);
        d[1] = make_uint4(w[4], w[5], w[6], w[7]);
      }
      __syncthreads();
    } else if (item < NWP + NMOD) {
      int it = item - NWP, layer = it / 96, cg0 = (it % 96) * 64;
      float* sc = (float*)smem;
      float* red = sc + 5 * 1024;
      for (int e = tid; e < 5 * 1024; e += NTHR) {
        int mb = e >> 10, k = e & 1023;
        float v = (mb < 4) ? p.c[mb * 1024 + k] : p.c_ctx[k];
        sc[e] = v / (1.f + __expf(-v));
      }
      __syncthreads();
      int col = cg0 + (tid & 63), kq = tid >> 6;
      const float* w = p.w_mod + (size_t)layer * DM * 6144 + col;
      float a0 = 0, a1 = 0, a2 = 0, a3 = 0, a4 = 0;
#pragma unroll 8
      for (int k = kq * 128; k < kq * 128 + 128; ++k) {
        float wv = w[(size_t)k * 6144];
        a0 += sc[k] * wv; a1 += sc[1024 + k] * wv; a2 += sc[2048 + k] * wv; a3 += sc[3072 + k] * wv; a4 += sc[4096 + k] * wv;
      }
      int c64 = tid & 63;
      red[(kq * 5 + 0) * 64 + c64] = a0; red[(kq * 5 + 1) * 64 + c64] = a1; red[(kq * 5 + 2) * 64 + c64] = a2;
      red[(kq * 5 + 3) * 64 + c64] = a3; red[(kq * 5 + 4) * 64 + c64] = a4;
      __syncthreads();
      for (int e = tid; e < 5 * 64; e += NTHR) {
        int mb = e >> 6, cc = e & 63;
        float s = 0.f;
#pragma unroll
        for (int q = 0; q < 8; ++q) s += red[(q * 5 + mb) * 64 + cc];
        p.mod[((size_t)layer * 5 + mb) * 6144 + cg0 + cc] = s + p.b_mod[layer * 6144 + cg0 + cc];
      }
      __syncthreads();
    } else if (item >= NWP + NMOD + NROPE) {
      unsigned* mx = (unsigned*)smem;
      for (int e = tid; e < NLAYER * 10; e += NTHR) mx[e] = 0u;
      __syncthreads();
      for (int e = tid; e < NLAYER * 6 * 64; e += NTHR) atomicMax(&mx[(e / 384) * 10 + (e % 384) / 64], __float_as_uint(fabsf(p.qk_norm[e])));
      for (int e = tid; e < NLAYER * 4 * 465; e += NTHR) atomicMax(&mx[(e / 1860) * 10 + 6 + (e % 1860) / 465], __float_as_uint(fabsf(p.rpb[e])));
      __syncthreads();
      if (tid < NLAYER * 8) {
        int l = tid >> 3, j = tid & 7; float v = 0.f;
        if (j < 3) v = 0.125f * LOG2E * 64.f * 1.02f * __uint_as_float(mx[l * 10 + 2 * j]) * __uint_as_float(mx[l * 10 + 2 * j + 1]);
        else if (j >= 4) v = LOG2E * __uint_as_float(mx[l * 10 + 6 + (j - 4)]);
        p.bounds[tid] = v;
      }
      __syncthreads();
    } else {
      int e = (item - NWP - NMOD) * NTHR + tid;
      int t = e >> 5, pi = e & 31;
      float pos = (pi < 16) ? (float)(t >> 6) : (float)(t & 63);
      float inv = exp2f(-(float)(pi & 15) * (13.287712379549449f / 16.0f));
      float ang = pos * inv;
      p.rope[2 * e] = __cosf(ang);
      p.rope[2 * e + 1] = __sinf(ang);
    }
  }
}

DI const float* xrow_src(const Params& p, int layer, int t) {
  const float* a = p.x; const float* b = p.out; const float* c = p.ctx; const float* d = p.xctx;
  asm volatile("" : "+v"(a), "+v"(b), "+v"(c), "+v"(d));
  if (t < TLAT) return (layer == 0 ? a : b) + (size_t)t * DM;
  return (layer == 0 ? c : d) + (size_t)(t - TLAT) * DM;
}
DI float* xrow_dst(const Params& p, int t) {
  float* b = p.out; float* d = p.xctx;
  asm volatile("" : "+v"(b), "+v"(d));
  if (t < TLAT) return b + (size_t)t * DM;
  return d + (size_t)(t - TLAT) * DM;
}
DI int mb_of(int t) { return t < TLAT ? (t >> 12) : 4; }

DI void norm_row(const Params& p, int layer, int which, int t, int lane) {
  const float* g = (which ? p.norm_ffn : p.norm_attn) + layer * DM;
  const float* xr = which ? (const float*)xrow_dst(p, t) : xrow_src(p, layer, t);
  const float* md = p.mod + ((size_t)layer * 5 + mb_of(t)) * 6144 + (which ? 3 * 1024 : 0);
  float4 v[4];
  float ss = 0.f;
#pragma unroll
  for (int j = 0; j < 4; ++j) {
    v[j] = *(const float4*)(xr + lane * 4 + 256 * j);
    ss += v[j].x * v[j].x + v[j].y * v[j].y + v[j].z * v[j].z + v[j].w * v[j].w;
  }
#pragma unroll
  for (int o = 32; o >= 1; o >>= 1) ss += __shfl_xor(ss, o);
  float r = rsqrtf(ss * (1.f / 1024.f) + EPSV);
#pragma unroll
  for (int j = 0; j < 4; ++j) {
    int col = lane * 4 + 256 * j;
    float4 gg = *(const float4*)(g + col);
    float4 sh = *(const float4*)(md + col);
    float4 sc = *(const float4*)(md + 1024 + col);
    float o0 = v[j].x * r * gg.x * (1.f + sc.x) + sh.x;
    float o1 = v[j].y * r * gg.y * (1.f + sc.y) + sh.y;
    float o2 = v[j].z * r * gg.z * (1.f + sc.z) + sh.z;
    float o3 = v[j].w * r * gg.w * (1.f + sc.w) + sh.w;
    *(uint2*)(p.H + (size_t)t * LDK + col) = make_uint2(pack_bf16(o0, o1), pack_bf16(o2, o3));
  }
}
template <int R>
DI void norm_rows(const Params& p, int layer, int which, int t0, int tstep, int lane) {
  const float* g = (which ? p.norm_ffn : p.norm_attn) + layer * DM;
  const float* md = p.mod + ((size_t)layer * 5 + mb_of(t0)) * 6144 + (which ? 3 * 1024 : 0);
  float4 v[R][4];
  float ss[R];
#pragma unroll
  for (int r = 0; r < R; ++r) {
    const float* xr = which ? (const float*)xrow_dst(p, t0 + r * tstep) : xrow_src(p, layer, t0 + r * tstep);
#pragma unroll
    for (int j = 0; j < 4; ++j) v[r][j] = *(const float4*)(xr + lane * 4 + 256 * j);
  }
#pragma unroll
  for (int r = 0; r < R; ++r) {
    ss[r] = 0.f;
#pragma unroll
    for (int j = 0; j < 4; ++j) ss[r] += v[r][j].x * v[r][j].x + v[r][j].y * v[r][j].y + v[r][j].z * v[r][j].z + v[r][j].w * v[r][j].w;
  }
#pragma unroll
  for (int o = 32; o >= 1; o >>= 1)
#pragma unroll
    for (int r = 0; r < R; ++r) ss[r] += __shfl_xor(ss[r], o);
#pragma unroll
  for (int r = 0; r < R; ++r) ss[r] = rsqrtf(ss[r] * (1.f / 1024.f) + EPSV);
#pragma unroll
  for (int j = 0; j < 4; ++j) {
    int col = lane * 4 + 256 * j;
    float4 gg = *(const float4*)(g + col);
    float4 sh = *(const float4*)(md + col);
    float4 sc = *(const float4*)(md + 1024 + col);
    float m0 = gg.x * (1.f + sc.x), m1 = gg.y * (1.f + sc.y), m2 = gg.z * (1.f + sc.z), m3 = gg.w * (1.f + sc.w);
#pragma unroll
    for (int r = 0; r < R; ++r)
      *(uint2*)(p.H + (size_t)(t0 + r * tstep) * LDK + col) =
          make_uint2(pack_bf16(v[r][j].x * ss[r] * m0 + sh.x, v[r][j].y * ss[r] * m1 + sh.y), pack_bf16(v[r][j].z * ss[r] * m2 + sh.z, v[r][j].w * ss[r] * m3 + sh.w));
  }
}
DI void norm_static(const Params& p, int layer, int which, int row0, int row1) {
  const int tid = tidx(), lane = tid & 63, wid = tid >> 6;
  for (int t = row0 + blockIdx.x * 8 + wid; t < row1; t += gridDim.x * 8) norm_row(p, layer, which, t, lane);
}
DI void norm_dyn(const Params& p, int layer, int which, int row0, int row1, unsigned* ctr) {
  const int tid = tidx(), lane = tid & 63, wid = tid >> 6;
  const int nchunk = (row1 - row0) >> 5;
  while (true) {
    int ch = grab(ctr);
    if (ch >= nchunk) break;
    norm_rows<4>(p, layer, which, row0 + ch * 32 + wid, 8, lane);
  }
}

namespace pg8 {
typedef unsigned short bf16_t;
constexpr int BM = 256, BK = 64, HALF = 128, HTB = HALF * BK * 2, STAGE_BYTES = 8 * HTB, NXCD = 8, WGM = 8;
DI int lds_byte(int r, int c) { const int st = (r >> 4) * 2 + (c >> 5), rr = r & 15, cc = c & 31, ob = rr * 64 + cc * 2; return st * 1024 + (ob ^ (((ob >> 9) & 1) << 5)); }
DI void stage_rc(int b, int& R, int& C) { const int st = b / 1024, sb = b % 1024, swz = sb ^ (((sb >> 9) & 1) << 5); R = (st >> 1) * 16 + swz / 64; C = (st & 1) * 32 + (swz % 64) / 2; }
DI int perm32(int rho) { const int n = rho >> 4, i = rho & 15; return 8 * (i >> 2) + 4 * n + (i & 3); }
struct Unit { int pm, pn; };
struct Gemm { const bf16_t* A; const bf16_t* Bt; int K; };

struct TileOrder {
  int nM, nN, nwg, G, c, remap;
  DI void init(int nM_, int nN_, int G_, int c_, int remap_) { nM = nM_; nN = nN_; nwg = nM * nN; G = G_; c = c_; remap = remap_; }
  DI bool next(int i, Unit& u) const {
    long L = (long)i * G + c;
    if (remap) {
      if (c >= 240) { if (i >= 3) return false; }
      else if (c >= 128 && c < 144 && i == 5) L = 4L * G + (c + 112);
      else if (c >= 144 && c < 160 && i == 5) L = 3L * G + (c + 96);
    }
    if (L >= nwg) return false;
    int wgid = (int)L; { const int q = nwg / NXCD, r = nwg % NXCD, xcd = wgid % NXCD, off = wgid / NXCD; wgid = (xcd < r ? xcd * (q + 1) : r * (q + 1) + (xcd - r) * q) + off; }
    const int nig = WGM * nN, gid = wgid / nig, fm = gid * WGM, gsz = (nM - fm) < WGM ? (nM - fm) : WGM;
    u.pm = fm + ((wgid % nig) % gsz); u.pn = (wgid % nig) / gsz; return true;
  }
};
struct OneUnit {
  Unit u; bool valid;
  DI bool next(int i, Unit& o) const { if (i != 0 || !valid) return false; o = u; return true; }
};

template <class Epi, class Sched>
DI void gemm_phase(LAS unsigned char* lds, const Gemm g, const Sched& S, const Epi& E) {
  const int tid = tidx(), wid = __builtin_amdgcn_readfirstlane(tid >> 6), lane = tid & 63, wr = wid >> 2, wc = wid & 3, fr = lane & 15, fq = lane >> 4;
  int K = g.K; asm volatile("" : "+s"(K));
  const int nt = K / BK;
  unsigned voffA[2], voffB[2];
#pragma unroll
  for (int i = 0; i < 2; ++i) {
    int R, C; stage_rc(tid * 16 + i * 8192, R, C);
    int Rb = R;
    if (Epi::BMAP == 1) Rb = (R & ~31) + perm32(R & 31);
    if (Epi::BMAP == 2) Rb = 64 * (R >> 5) + perm32(R & 31);
    voffA[i] = (unsigned)(R * K + C) * 2u; voffB[i] = (unsigned)(Rb * K + C) * 2u;
  }
  const size_t kstep = (size_t)(BK * 2);
  const size_t hstep = (size_t)HALF * K * 2;
  const size_t hstepB = (Epi::BMAP == 2) ? (size_t)32 * K * 2 : hstep;
  const size_t tstep = 2 * hstep;
  const unsigned ldsw = (unsigned)wid * 1024u;
  const int aoff = lds_byte(wr * 64 + fr, fq * 8), boff = lds_byte(wc * 32 + fr, fq * 8);
#define PG8_SA(b, h) (((b) * 2 + (h)) * HTB)
#define PG8_SB(b, h) ((4 + (b) * 2 + (h)) * HTB)
#define PG8_STAGE(bufoff, gbase, voff) do { _Pragma("unroll") for (int _i = 0; _i < 2; ++_i) \
    __builtin_amdgcn_global_load_lds((const unsigned*)((const char*)(gbase) + (voff)[_i]), (LAS unsigned*)(lds + (bufoff) + ldsw + _i * 8192), 16, 0, 0); } while (0)
#define PG8_LDA(dst, b, h) do { _Pragma("unroll") for (int m = 0; m < 4; ++m) _Pragma("unroll") for (int k = 0; k < 2; ++k) dst[m][k] = *(const LAS bf16x8*)(lds + PG8_SA(b, h) + aoff + m * 2048 + k * 1024); } while (0)
#define PG8_LDB(dst, b, h) do { _Pragma("unroll") for (int n = 0; n < 2; ++n) _Pragma("unroll") for (int k = 0; k < 2; ++k) dst[n][k] = *(const LAS bf16x8*)(lds + PG8_SB(b, h) + boff + n * 2048 + k * 1024); } while (0)
#define PG8_MMA(ai, bj, At, Bt) do { __builtin_amdgcn_s_setprio(1); _Pragma("unroll") for (int m = 0; m < 4; ++m) _Pragma("unroll") for (int n = 0; n < 2; ++n) _Pragma("unroll") for (int k = 0; k < 2; ++k) \
    acc[ai][bj][m][n] = __builtin_amdgcn_mfma_f32_16x16x32_bf16(Bt[n][k], At[m][k], acc[ai][bj][m][n], 0, 0, 0); __builtin_amdgcn_s_setprio(0); } while (0)
#define PG8_WAIT_V(n) asm volatile("s_waitcnt vmcnt(" #n ")" ::: "memory")
#define PG8_WAIT_L(n) asm volatile("s_waitcnt lgkmcnt(" #n ")" ::: "memory")
#define PG8_BAR __builtin_amdgcn_s_barrier()
#define PG8_SCHED __builtin_amdgcn_sched_barrier(0)
  Unit cur, nxt; int ui = 0;
  if (!S.next(0, cur)) return;
  f32x4 acc[2][2][4][2];
#pragma unroll
  for (int a = 0; a < 2; ++a)
#pragma unroll
    for (int b = 0; b < 2; ++b)
#pragma unroll
      for (int m = 0; m < 4; ++m)
#pragma unroll
        for (int n = 0; n < 2; ++n) acc[a][b][m][n] = (f32x4){0.f, 0.f, 0.f, 0.f};
  bf16x8 At[4][2], B0[2][2], B1[2][2];
  const char* cA = (const char*)g.A + (size_t)cur.pm * tstep; const char* cB = (const char*)g.Bt + (size_t)cur.pn * tstep;
  PG8_STAGE(PG8_SB(0, 0), cB, voffB); PG8_STAGE(PG8_SA(0, 0), cA, voffA); PG8_STAGE(PG8_SB(0, 1), cB + hstepB, voffB); PG8_STAGE(PG8_SA(0, 1), cA + hstep, voffA);
  if (wr == 1) PG8_BAR;
  PG8_WAIT_V(4); PG8_BAR;
  PG8_STAGE(PG8_SB(1, 0), cB + kstep, voffB); PG8_STAGE(PG8_SA(1, 0), cA + kstep, voffA); PG8_STAGE(PG8_SB(1, 1), cB + hstepB + kstep, voffB);
  PG8_WAIT_V(6); PG8_BAR;
  for (;;) {
    const bool has_next = S.next(ui + 1, nxt);
    const char* nA = has_next ? (const char*)g.A + (size_t)nxt.pm * tstep : cA; const char* nB = has_next ? (const char*)g.Bt + (size_t)nxt.pn * tstep : cB;
    for (int t = 0; t < nt; t += 2) {
      const bool last = (t == nt - 2);
      const char* a1 = cA + (size_t)(t + 1) * kstep;
      const char* a2 = last ? nA : cA + (size_t)(t + 2) * kstep; const char* b2 = last ? nB : cB + (size_t)(t + 2) * kstep;
      const char* a3 = a2 + kstep; const char* b3 = b2 + kstep;
      PG8_LDB(B0, 0, 0); PG8_SCHED; PG8_LDA(At, 0, 0); PG8_STAGE(PG8_SA(1, 1), a1 + hstep, voffA);
      PG8_WAIT_L(8); PG8_BAR; PG8_WAIT_L(0); PG8_MMA(0, 0, At, B0); PG8_BAR; PG8_SCHED;
      PG8_LDB(B1, 0, 1); PG8_STAGE(PG8_SB(0, 0), b2, voffB);
      PG8_BAR; PG8_WAIT_L(0); PG8_MMA(0, 1, At, B1); PG8_BAR;
      PG8_LDA(At, 0, 1); PG8_STAGE(PG8_SA(0, 0), a2, voffA);
      PG8_BAR; PG8_WAIT_L(0); PG8_MMA(1, 0, At, B0); PG8_BAR; PG8_SCHED;
      PG8_STAGE(PG8_SB(0, 1), b2 + hstepB, voffB);
      PG8_WAIT_V(6); PG8_BAR; PG8_MMA(1, 1, At, B1); PG8_BAR;
      PG8_LDB(B0, 1, 0); PG8_SCHED; PG8_LDA(At, 1, 0); PG8_STAGE(PG8_SA(0, 1), a2 + hstep, voffA);
      PG8_WAIT_L(8); PG8_BAR; PG8_WAIT_L(0); PG8_MMA(0, 0, At, B0); PG8_BAR; PG8_SCHED;
      PG8_LDB(B1, 1, 1); PG8_STAGE(PG8_SB(1, 0), b3, voffB);
      PG8_BAR; PG8_WAIT_L(0); PG8_MMA(0, 1, At, B1); PG8_BAR;
      PG8_LDA(At, 1, 1); PG8_STAGE(PG8_SA(1, 0), a3, voffA);
      PG8_BAR; PG8_WAIT_L(0); PG8_MMA(1, 0, At, B0); PG8_BAR; PG8_SCHED;
      PG8_STAGE(PG8_SB(1, 1), b3 + hstepB, voffB);
      PG8_WAIT_V(6); PG8_BAR; PG8_MMA(1, 1, At, B1); PG8_BAR;
    }
    E(acc, cur, wr, wc, fr, fq);
    if (!has_next) break;
#pragma unroll
    for (int a = 0; a < 2; ++a)
#pragma unroll
      for (int b = 0; b < 2; ++b)
#pragma unroll
        for (int m = 0; m < 4; ++m)
#pragma unroll
          for (int n = 0; n < 2; ++n) acc[a][b][m][n] = (f32x4){0.f, 0.f, 0.f, 0.f};
    cur = nxt; cA = nA; cB = nB; ++ui;
  }
  PG8_WAIT_V(0);
  if (wr == 0) PG8_BAR;
  PG8_BAR;
#undef PG8_SA
#undef PG8_SB
#undef PG8_STAGE
#undef PG8_LDA
#undef PG8_LDB
#undef PG8_MMA
#undef PG8_WAIT_V
#undef PG8_WAIT_L
#undef PG8_BAR
#undef PG8_SCHED
}

struct EpiRes {
  static constexpr int BMAP = 0;
  const float* src; float* dst; const float* gate;
  DI void operator()(const f32x4 (&acc)[2][2][4][2], const Unit& u, int wr, int wc, int fr, int fq) const {
    asm volatile("" ::: "memory");
    const int row0 = u.pm * BM + wr * 64 + fr, col0 = u.pn * BM + wc * 32 + 4 * fq;
    f32x4 gv[2][2];
#pragma unroll
    for (int bj = 0; bj < 2; ++bj)
#pragma unroll
      for (int n = 0; n < 2; ++n) gv[bj][n] = *(const f32x4*)(gate + col0 + bj * HALF + n * 16);
#pragma unroll
    for (int ai = 0; ai < 2; ++ai)
#pragma unroll
      for (int m = 0; m < 4; ++m) {
        const size_t ro = (size_t)(row0 + ai * HALF + m * 16) * DM + col0;
#pragma unroll
        for (int bj = 0; bj < 2; ++bj)
#pragma unroll
          for (int n = 0; n < 2; ++n) {
            f32x4 s = *(const f32x4*)(src + ro + bj * HALF + n * 16);
            *(f32x4*)(dst + ro + bj * HALF + n * 16) = s + gv[bj][n] * acc[ai][bj][m][n];
          }
      }
  }
};
struct EpiGU {
  static constexpr int BMAP = 1;
  u16* act;
  DI void operator()(const f32x4 (&acc)[2][2][4][2], const Unit& u, int wr, int wc, int fr, int fq) const {
    asm volatile("" ::: "memory");
    const int row0 = u.pm * BM + wr * 64 + fr, col0 = u.pn * HALF + wc * 32 + 8 * fq;
#pragma unroll
    for (int ai = 0; ai < 2; ++ai)
#pragma unroll
      for (int m = 0; m < 4; ++m) {
        float a[8];
#pragma unroll
        for (int n = 0; n < 2; ++n)
#pragma unroll
          for (int e = 0; e < 4; ++e) {
            float gte = acc[ai][0][m][n][e], up = acc[ai][1][m][n][e];
            a[n * 4 + e] = gte * __builtin_amdgcn_rcpf(1.f + __builtin_amdgcn_exp2f(-gte * LOG2E)) * up;
          }
        *(uint4*)(act + (size_t)(row0 + ai * HALF + m * 16) * FFN + col0) =
            make_uint4(pack_bf16(a[0], a[1]), pack_bf16(a[2], a[3]), pack_bf16(a[4], a[5]), pack_bf16(a[6], a[7]));
      }
  }
};
struct EpiQKV {
  static constexpr int BMAP = 2;
  u16* qkv; const float* qkn; const float* rope; int rowbase;
  DI void operator()(const f32x4 (&acc)[2][2][4][2], const Unit& u, int wr, int wc, int fr, int fq) const {
    asm volatile("" ::: "memory");
    const int chunk = u.pn * 4 + wc;
    const bool isV = (chunk == 8 || chunk == 9 || (chunk >= 18 && chunk <= 21) || chunk >= 30);
    int gi = 0;
    if (chunk < 6) gi = 0; else if (chunk < 8) gi = 1; else if (chunk < 14) gi = 2; else if (chunk < 18) gi = 3;
    else if (chunk < 28) gi = 4; else gi = 5;
    const bool ropeT = (gi == 0 || gi == 1 || gi == 4 || gi == 5) && rowbase == 0;
    const float* gam = qkn + gi * 64;
    const float qs = (gi == 0 || gi == 2 || gi == 4) ? 0.125f * LOG2E : 1.f;
    f32x4 g4[2][2];
#pragma unroll
    for (int bj = 0; bj < 2; ++bj)
#pragma unroll
      for (int n = 0; n < 2; ++n) g4[bj][n] = *(const f32x4*)(gam + 32 * bj + 8 * fq + 4 * n);
#pragma unroll
    for (int ai = 0; ai < 2; ++ai)
#pragma unroll
      for (int m = 0; m < 4; ++m) {
        const int t = u.pm * BM + ai * HALF + wr * 64 + m * 16 + fr;
        int b, pos;
        if (rowbase == 0) { b = t >> 12; pos = t & 4095; } else { b = t >> 8; pos = 4096 + (t & 255); }
        u16* base = qkv + (size_t)(b * 32 + chunk) * LTOT * 64;
        if (isV) {
#pragma unroll
          for (int bj = 0; bj < 2; ++bj)
#pragma unroll
            for (int n = 0; n < 2; ++n)
#pragma unroll
              for (int e = 0; e < 4; ++e) {
                int d = 32 * bj + 8 * fq + 4 * n + e;
                base[(size_t)d * LTOT + pos] = f2bf(acc[ai][bj][m][n][e]);
              }
        } else {
          float ss = 0.f;
#pragma unroll
          for (int bj = 0; bj < 2; ++bj)
#pragma unroll
            for (int n = 0; n < 2; ++n)
#pragma unroll
              for (int e = 0; e < 4; ++e) ss += acc[ai][bj][m][n][e] * acc[ai][bj][m][n][e];
          ss += __shfl_xor(ss, 16);
          ss += __shfl_xor(ss, 32);
          const float rinv = rsqrtf(ss * (1.f / 64.f) + EPSV);
          float o1[8], o2[8];
#pragma unroll
          for (int n = 0; n < 2; ++n) {
            f32x4 cs0 = (f32x4){1.f, 0.f, 1.f, 0.f}, cs1 = cs0;
            if (ropeT) { const float* rp = rope + (size_t)pos * 64 + 2 * (8 * fq + 4 * n); cs0 = *(const f32x4*)rp; cs1 = *(const f32x4*)(rp + 4); }
#pragma unroll
            for (int e = 0; e < 4; ++e) {
              float x1 = acc[ai][0][m][n][e] * (rinv * qs) * g4[0][n][e];
              float x2 = acc[ai][1][m][n][e] * (rinv * qs) * g4[1][n][e];
              float c = (e < 2) ? cs0[2 * e] : cs1[2 * (e - 2)], s = (e < 2) ? cs0[2 * e + 1] : cs1[2 * (e - 2) + 1];
              o1[n * 4 + e] = x1 * c - x2 * s;
              o2[n * 4 + e] = x2 * c + x1 * s;
            }
          }
          u16* dst = base + (size_t)pos * 64 + 8 * fq;
          *(uint4*)(dst) = make_uint4(pack_bf16(o1[0], o1[1]), pack_bf16(o1[2], o1[3]), pack_bf16(o1[4], o1[5]), pack_bf16(o1[6], o1[7]));
          *(uint4*)(dst + 32) = make_uint4(pack_bf16(o2[0], o2[1]), pack_bf16(o2[2], o2[3]), pack_bf16(o2[4], o2[5]), pack_bf16(o2[6], o2[7]));
        }
      }
  }
};
}

constexpr int KROW = 144, VROW = 136;
constexpr int KT_B = 64 * KROW, VT_B = 64 * VROW, KV_B = KT_B + VT_B;
constexpr int RPB_OFF = 2 * KV_B;
constexpr int NAT_C = 384, NAT_B = 256, NAT_A = 384, NAT_LAT = NAT_C + NAT_B + NAT_A, NAT_CTX = 64;

DI void attn_item(const Params& p, int layer, int item, char* smem) {
  const int tid = tidx(), lane = tid & 63, wid = tid >> 6, l32 = lane & 31, h = lane >> 5;
  int mode, b, hh, qb;
  if (item < NAT_C) { mode = 0; b = item / 96; int rem = item % 96; hh = rem >> 4; qb = rem & 15; }
  else if (item < NAT_C + NAT_B) { int it = item - NAT_C; mode = 1; b = it >> 6; hh = (it & 63) >> 4; qb = it & 15; }
  else if (item < NAT_LAT) { int it = item - NAT_C - NAT_B; mode = 2; b = it / 96; int rem = it % 96; hh = rem >> 4; qb = rem & 15; }
  else { int it = item - NAT_LAT; mode = 3; b = it >> 4; hh = it & 15; qb = 0; }

  int qchunk, kchunk, vchunk, head16, t0 = 0, t1 = 0, qpos0 = qb * 256;
  bool hasSink = false; float sinkv = 0.f;
  int maskmode = 0;
  if (mode == 0) { qchunk = 22 + hh; kchunk = 28 + hh / 3; vchunk = 30 + hh / 3; head16 = 10 + hh; t0 = 0; t1 = 64; }
  else if (mode == 1) {
    qchunk = 10 + hh; kchunk = 14 + hh; vchunk = 18 + hh; head16 = 6 + hh; maskmode = 1;
    t0 = min(max(4 * qb - 4, 0), 56); t1 = min(max(4 * qb + 3 - 4, 0), 56) + 8;
  } else if (mode == 2) {
    qchunk = hh; kchunk = 6 + hh / 3; vchunk = 8 + hh / 3; head16 = hh; maskmode = 2;
    t0 = max(0, 4 * qb - 2); t1 = min(64, 4 * qb + 6); hasSink = true; sinkv = p.sink[layer * 6 + hh];
  } else {
    head16 = hh; qpos0 = 4096;
    if (hh < 6) { qchunk = hh; kchunk = 6 + hh / 3; vchunk = 8 + hh / 3; hasSink = true; sinkv = p.sink[layer * 6 + hh]; }
    else if (hh < 10) { int hb = hh - 6; qchunk = 10 + hb; kchunk = 14 + hb; vchunk = 18 + hb; }
    else { int hc = hh - 10; qchunk = 22 + hc; kchunk = 28 + hc / 3; vchunk = 30 + hc / 3; }
  }
  const int n_it = 4 + (t1 - t0);
  const u16* Qb = p.QKV + (size_t)(b * 32 + qchunk) * LTOT * 64;
  const u16* Kb = p.QKV + (size_t)(b * 32 + kchunk) * LTOT * 64;
  const u16* Vb = p.QKV + (size_t)(b * 32 + vchunk) * LTOT * 64;
  float* s_rpb = (float*)(smem + RPB_OFF);
  if (mode == 1) {
    const float* rp = p.rpb + (size_t)(layer * 4 + hh) * 465;
    for (int e = tid; e < 465; e += NTHR) s_rpb[e] = rp[e] * LOG2E;
  }

  const int qpos = qpos0 + wid * 32 + l32;
  bf16x8 qf[4];
#pragma unroll
  for (int s = 0; s < 4; ++s) qf[s] = *(const bf16x8*)(Qb + (size_t)qpos * 64 + s * 16 + h * 8);

  f32x16 o0, o1;
#pragma unroll
  for (int r = 0; r < 16; ++r) { o0[r] = 0.f; o1[r] = 0.f; }
  const int btype = (mode == 3) ? (hh < 6 ? 0 : (hh < 10 ? 1 : 2)) : (mode == 0 ? 2 : (mode == 1 ? 1 : 0));
  float m_fix = p.bounds[layer * 8 + btype];
  if (mode == 1) m_fix += p.bounds[layer * 8 + 4 + hh];
  f32x16 cinit, lacc;
#pragma unroll
  for (int r = 0; r < 16; ++r) { cinit[r] = -m_fix; lacc[r] = 0.f; }
  const bf16x8 ones = {(short)0x3F80, (short)0x3F80, (short)0x3F80, (short)0x3F80, (short)0x3F80, (short)0x3F80, (short)0x3F80, (short)0x3F80};

  const int lr = tid >> 3, lc = tid & 7;
  uint4 ka0, va0, kb0, vb0;
#define TILE_OF(it) ((it) < 4 ? 64 + (it) : t0 + (it) - 4)
#define AGLOAD(K0, V0, tile)                                                           \
  {                                                                                    \
    K0 = *(const uint4*)(Kb + (size_t)((tile) * 64 + lr) * 64 + lc * 8);               \
    V0 = *(const uint4*)(Vb + (size_t)(lr) * LTOT + (tile) * 64 + lc * 8);             \
  }
#define ASWRITE(K0, V0, buf)                                                           \
  {                                                                                    \
    *(uint4*)(smem + (buf) * KV_B + (lr) * KROW + lc * 16) = K0;                       \
    char* vd = smem + (buf) * KV_B + KT_B + (lr) * VROW + lc * 16;                     \
    *(uint2*)(vd) = make_uint2(V0.x, V0.y);                                            \
    *(uint2*)(vd + 8) = make_uint2(V0.z, V0.w);                                        \
  }

  const int tq = qb * 256 + wid * 32 + l32;
  auto compute = [&](const int bufsel, const int tile) {
    bool skip = false;
    if (tile < 64) {
      if (maskmode == 1) {
        int qr = (qb * 256 + wid * 32) >> 6;
        int krw = min(max(qr - 4, 0), 56);
        skip = (tile < krw) || (tile >= krw + 8);
      } else if (maskmode == 2) {
        int q0w = qb * 256 + wid * 32, tk0 = tile * 64;
        skip = (tk0 > q0w + 31 + 128) || (tk0 + 63 < q0w - 128);
      }
    }
    if (!skip) {
      const char* sK = smem + bufsel * KV_B;
      const char* sV = sK + KT_B;
      f32x16 S[2];
      __builtin_amdgcn_s_setprio(1);
#pragma unroll
      for (int kt = 0; kt < 2; ++kt) {
#pragma unroll
        for (int s = 0; s < 4; ++s) {
          bf16x8 kf = *(const bf16x8*)(sK + (kt * 32 + l32) * KROW + s * 32 + h * 16);
          S[kt] = MFMA32(kf, qf[s], s == 0 ? cinit : S[kt]);
        }
      }
      __builtin_amdgcn_s_setprio(0);
      if (tile < 64 && maskmode == 1) {
        int qr = tq >> 6, qc = tq & 63;
        int ws = min(max(qc - 8, 0), 48);
        int dr = tile - qr + 7;
#pragma unroll
        for (int kt = 0; kt < 2; ++kt)
#pragma unroll
          for (int r = 0; r < 16; ++r) {
            int kc = kt * 32 + crow(r, h);
            bool ok = (unsigned)(kc - ws) < 16u;
            int bi = ok ? (dr * 31 + kc - qc + 15) : 0;
            float bv = s_rpb[bi];
            S[kt][r] = ok ? (S[kt][r] + bv) : -INFINITY;
          }
      } else if (tile < 64 && maskmode == 2) {
#pragma unroll
        for (int kt = 0; kt < 2; ++kt)
#pragma unroll
          for (int r = 0; r < 16; ++r) {
            int tk = tile * 64 + kt * 32 + crow(r, h);
            int dd = tq - tk;
            bool ok = (dd <= 128) && (dd >= -128);
            S[kt][r] = ok ? S[kt][r] : -INFINITY;
          }
      }
#pragma unroll
      for (int r = 0; r < 16; ++r) {
        S[0][r] = __builtin_amdgcn_exp2f(S[0][r]);
        S[1][r] = __builtin_amdgcn_exp2f(S[1][r]);
      }
#pragma unroll
      for (int kt = 0; kt < 2; ++kt)
#pragma unroll
        for (int s2 = 0; s2 < 2; ++s2) {
          uint4 pw;
          pw.x = pack_bf16(S[kt][8 * s2 + 0], S[kt][8 * s2 + 1]);
          pw.y = pack_bf16(S[kt][8 * s2 + 2], S[kt][8 * s2 + 3]);
          pw.z = pack_bf16(S[kt][8 * s2 + 4], S[kt][8 * s2 + 5]);
          pw.w = pack_bf16(S[kt][8 * s2 + 6], S[kt][8 * s2 + 7]);
          bf16x8 pf = __builtin_bit_cast(bf16x8, pw);
          int koff = (kt * 32 + 16 * s2 + 4 * h) * 2;
          {
            uint2 va = *(const uint2*)(sV + l32 * VROW + koff);
            uint2 vb = *(const uint2*)(sV + l32 * VROW + koff + 16);
            bf16x8 vf = __builtin_bit_cast(bf16x8, make_uint4(va.x, va.y, vb.x, vb.y));
            o0 = MFMA32(vf, pf, o0);
            lacc = MFMA32(ones, pf, lacc);
          }
          {
            uint2 va = *(const uint2*)(sV + (32 + l32) * VROW + koff);
            uint2 vb = *(const uint2*)(sV + (32 + l32) * VROW + koff + 16);
            bf16x8 vf = __builtin_bit_cast(bf16x8, make_uint4(va.x, va.y, vb.x, vb.y));
            o1 = MFMA32(vf, pf, o1);
          }
        }
    }
  };

  AGLOAD(ka0, va0, TILE_OF(0));
  if (n_it > 1) { AGLOAD(kb0, vb0, TILE_OF(1)); }
  ASWRITE(ka0, va0, 0);
  if (n_it > 2) { AGLOAD(ka0, va0, TILE_OF(2)); }
  __syncthreads();
  for (int it = 0; it < n_it; it += 2) {
    if (it + 1 < n_it) { ASWRITE(kb0, vb0, 1); }
    if (it + 3 < n_it) { AGLOAD(kb0, vb0, TILE_OF(it + 3)); }
    __builtin_amdgcn_sched_barrier(0);
    compute(0, TILE_OF(it));
    __syncthreads();
    if (it + 1 < n_it) {
      if (it + 2 < n_it) { ASWRITE(ka0, va0, 0); }
      if (it + 4 < n_it) { AGLOAD(ka0, va0, TILE_OF(it + 4)); }
      __builtin_amdgcn_sched_barrier(0);
      compute(1, TILE_OF(it + 1));
      __syncthreads();
    }
  }
#undef AGLOAD
#undef ASWRITE
#undef TILE_OF

  float l_tot = lacc[0];
  if (hasSink) l_tot += __builtin_amdgcn_exp2f(sinkv * LOG2E - m_fix);
  float inv = 1.f / l_tot;
  int T = (mode == 3) ? (TLAT + b * 256 + (qpos - 4096)) : (b * 4096 + qpos);
  u16* od = p.O + (size_t)T * LDK + head16 * 64;
#pragma unroll
  for (int g = 0; g < 4; ++g) {
    int d0 = 8 * g + 4 * h;
    *(uint2*)(od + d0) = make_uint2(pack_bf16(o0[4 * g] * inv, o0[4 * g + 1] * inv), pack_bf16(o0[4 * g + 2] * inv, o0[4 * g + 3] * inv));
    *(uint2*)(od + 32 + d0) = make_uint2(pack_bf16(o1[4 * g] * inv, o1[4 * g + 1] * inv), pack_bf16(o1[4 * g + 2] * inv, o1[4 * g + 3] * inv));
  }
}

DI void run_gphase(const Params& p, int g, char* smem, int coff = 0) {
  using namespace pg8;
  LAS unsigned char* lds = (LAS unsigned char*)smem;
  const int layer = (g - 1) / 7, ph = (g - 1) % 7 + 1;
  const bool hasc = (g + 1 <= 23);
  const int cl = g / 7;
  const int bid = blockIdx.x, nb = gridDim.x;
  const float* xin_lat; const float* xin_ctx; float* xo_lat = p.out; float* xo_ctx = p.xctx;
  { const float* a_ = p.x; const float* c_ = p.ctx; asm volatile("" : "+s"(a_), "+s"(c_));
    float* b_ = p.out; float* d_ = p.xctx; asm volatile("" : "+s"(b_), "+s"(d_));
    xin_lat = (layer == 0) ? a_ : (const float*)b_; xin_ctx = (cl == 0) ? c_ : (const float*)d_; xo_lat = b_; xo_ctx = d_; }
  switch (ph) {
    case 1: {
      if (hasc) {
        OneUnit S; S.u.pm = bid & 3; S.u.pn = bid >> 2; S.valid = bid < 32;
        EpiQKV E; E.qkv = p.QKV; E.qkn = p.qk_norm + cl * 6 * 64; E.rope = p.rope; E.rowbase = TLAT;
        gemm_phase(lds, Gemm{p.H + (size_t)TLAT * LDK, p.wt_in + (size_t)cl * INW * LDK, DM}, S, E);
      }
      norm_dyn(p, layer, 0, 0, TLAT, &p.counters[32 + g + coff]);
    } break;
    case 2: {
      TileOrder S; S.init(64, 8, nb, bid, 0);
      EpiQKV E; E.qkv = p.QKV; E.qkn = p.qk_norm + layer * 6 * 64; E.rope = p.rope; E.rowbase = 0;
      gemm_phase(lds, Gemm{p.H, p.wt_in + (size_t)layer * INW * LDK, DM}, S, E);
      if (hasc)
        for (int i = bid; i < NAT_CTX; i += nb) attn_item(p, cl, NAT_LAT + i, smem);
    } break;
    case 3: {
      const int nctx = hasc ? 16 : 0;
      for (int it = grab(&p.counters[g + coff]); it < NAT_LAT + nctx; it = grab(&p.counters[g + coff])) {
        if (it < NAT_C) attn_item(p, layer, it, smem);
        else if (it < NAT_C + nctx) {
          int j = it - NAT_C;
          OneUnit S; S.u.pm = j & 3; S.u.pn = j >> 2; S.valid = true;
          EpiRes E; E.src = xin_ctx; E.dst = xo_ctx; E.gate = p.mod + ((size_t)cl * 5 + 4) * 6144 + 2 * 1024;
          gemm_phase(lds, Gemm{p.O + (size_t)TLAT * LDK, p.wt_out + (size_t)cl * DM * LDK, DM}, S, E);
        } else attn_item(p, layer, it - nctx, smem);
      }
    } break;
    case 4: {
      TileOrder S; S.init(64, 4, nb, bid, 0);
      Unit u0;
      for (int i = 0; S.next(i, u0); ++i) {
        OneUnit S1; S1.u = u0; S1.valid = true;
        EpiRes E; E.src = xin_lat; E.dst = xo_lat; E.gate = p.mod + ((size_t)layer * 5 + (u0.pm >> 4)) * 6144 + 2 * 1024;
        gemm_phase(lds, Gemm{p.O, p.wt_out + (size_t)layer * DM * LDK, DM}, S1, E);
      }
      if (hasc) norm_static(p, cl, 1, TLAT, TTOT);
    } break;
    case 5: {
      if (hasc) {
        OneUnit S; S.u.pm = bid & 3; S.u.pn = bid >> 2; S.valid = bid < 88;
        EpiGU E; E.act = p.ACT + (size_t)TLAT * LDF;
        gemm_phase(lds, Gemm{p.H + (size_t)TLAT * LDK, p.wt_gu + (size_t)cl * GUW * LDK, DM}, S, E);
      }
      norm_dyn(p, layer, 1, 0, TLAT, &p.counters[32 + g + coff]);
    } break;
    case 6: {
      if (hasc) {
        int j = (nb == 256) ? bid - 240 : bid;
        OneUnit S; S.u.pm = j & 3; S.u.pn = (j >> 2) & 3; S.valid = (j >= 0 && j < 16);
        EpiRes E; E.src = xo_ctx; E.dst = xo_ctx; E.gate = p.mod + ((size_t)cl * 5 + 4) * 6144 + 5 * 1024;
        gemm_phase(lds, Gemm{p.ACT + (size_t)TLAT * LDF, p.wt_down + (size_t)cl * DM * LDF, FFN}, S, E);
      }
      TileOrder S; S.init(64, 22, nb, bid, (hasc && nb == 256) ? 1 : 0);
      EpiGU E; E.act = p.ACT;
      gemm_phase(lds, Gemm{p.H, p.wt_gu + (size_t)layer * GUW * LDK, DM}, S, E);
    } break;
    case 7: {
      TileOrder S; S.init(64, 4, nb, bid, 0);
      Unit u0;
      for (int i = 0; S.next(i, u0); ++i) {
        OneUnit S1; S1.u = u0; S1.valid = true;
        EpiRes E; E.src = xo_lat; E.dst = xo_lat; E.gate = p.mod + ((size_t)layer * 5 + (u0.pm >> 4)) * 6144 + 5 * 1024;
        gemm_phase(lds, Gemm{p.ACT, p.wt_down + (size_t)layer * DM * LDF, FFN}, S1, E);
      }
      if (hasc) norm_static(p, cl, 0, TLAT, TTOT);
    } break;
  }
}

#define XB_XCNT(j)  (256  + 64 * (j))
#define XB_XSUB(j)  (1280 + 64 * (j))
#define XB_XGEN(j)  (2304 + 64 * (j))
#define XB_TOP      3328
#define XB_TOPGEN   3392
#define XCD_BAR_WORDS 3456
#define LAS __attribute__((address_space(3)))
DI unsigned xb_ld(unsigned* p) { return __hip_atomic_load(p, __ATOMIC_RELAXED, __HIP_MEMORY_SCOPE_AGENT); }
DI unsigned xb_add(unsigned* p, unsigned v) { return __hip_atomic_fetch_add(p, v, __ATOMIC_RELAXED, __HIP_MEMORY_SCOPE_AGENT); }
DI unsigned xb_xcc_id() { return (unsigned)__builtin_amdgcn_s_getreg((3 << 11) | 20) & 0xFu; }
struct XcdBarrier { unsigned* bar; unsigned x; volatile LAS unsigned* st; };
DI XcdBarrier xcd_barrier_post(unsigned* bar, volatile LAS unsigned* st) {
  XcdBarrier b; b.bar = bar; b.x = xb_xcc_id(); b.st = st;
  if (threadIdx.x == 0) (void)xb_add(&bar[XB_XCNT(b.x)], 1u);
  return b;
}
DI void xcd_barrier_complete(unsigned* bar, unsigned x, unsigned& nloc, unsigned& nx) {
  const unsigned G = gridDim.x;
  unsigned sum, cnt, mine;
  for (;;) {
    sum = 0u; cnt = 0u; mine = 0u;
#pragma unroll
    for (unsigned j = 0; j < 16; ++j) { const unsigned c = xb_ld(&bar[XB_XCNT(j)]); sum += c; cnt += (c > 0u) ? 1u : 0u; mine = (j == x) ? c : mine; }
    if (sum == G) break;
    __builtin_amdgcn_s_sleep(1);
  }
  nloc = mine > 0u ? mine : 1u; nx = cnt > 0u ? cnt : 1u;
}
DI void xcd_barrier(const XcdBarrier& b) {
  asm volatile("s_waitcnt vmcnt(0)" ::: "memory");
  __syncthreads();
  if (threadIdx.x == 0) {
    unsigned* bar = b.bar;
    unsigned bx = b.x;
    asm volatile("" : "+s"(bx));
    __builtin_amdgcn_s_waitcnt(0);
    unsigned nloc = b.st[0], nx = b.st[1];
    if (nloc == 0u) { xcd_barrier_complete(bar, bx, nloc, nx); b.st[0] = nloc; b.st[1] = nx; }
    const unsigned old = xb_add(&bar[XB_XSUB(bx)], 1u);
    const unsigned gen = old / nloc;
    if (old + 1u == (gen + 1u) * nloc) {
      __builtin_amdgcn_fence(__ATOMIC_RELEASE, "agent");
      asm volatile("s_waitcnt vmcnt(0)" ::: "memory");
      const unsigned og = xb_add(&bar[XB_TOP], 1u);
      const unsigned tg = og / nx;
      if (og + 1u == (tg + 1u) * nx) xb_add(&bar[XB_TOPGEN], 1u);
      else { while (xb_ld(&bar[XB_TOPGEN]) == tg) __builtin_amdgcn_s_sleep(1); }
      __builtin_amdgcn_fence(__ATOMIC_ACQUIRE, "agent");
      xb_add(&bar[XB_XGEN(bx)], 1u);
      asm volatile("s_waitcnt vmcnt(0)" ::: "memory");
    } else {
      while (xb_ld(&bar[XB_XGEN(bx)]) == gen) __builtin_amdgcn_s_sleep(1);
      __builtin_amdgcn_fence(__ATOMIC_ACQUIRE, "agent");
      asm volatile("s_waitcnt vmcnt(0)" ::: "memory");
    }
  }
  __syncthreads();
}


__global__ void __launch_bounds__(512, 2) fwd_megakernel(Params p) {
  extern __shared__ __attribute__((aligned(16))) unsigned char dsm[];
  char* smem = (char*)dsm;
  cg::grid_group grid = cg::this_grid();
  if (threadIdx.x == 0) *(uint4*)(dsm + 131072) = make_uint4(0u, 0u, 0u, 0u);
  __syncthreads();
  XcdBarrier xb = xcd_barrier_post(p.counters + 1024, (volatile LAS unsigned*)(dsm + 131072));
  phase0(p, smem);
  grid.sync();
  norm_static(p, 0, 0, TLAT, TTOT);
  xcd_barrier(xb);
  for (int g = 1; g <= 7 * NLAYER; ++g) {
    run_gphase(p, g, smem);
#ifdef PROBE_DOUBLE
    if ((g - 1) % 7 + 1 == PROBE_DOUBLE) { xcd_barrier(xb); run_gphase(p, g, smem, 100); }
#endif
    if (g < 7 * NLAYER) xcd_barrier(xb);
  }
}

extern "C" void kernel_launch(void* const* d_in, const int* in_sizes, int n_in, void* d_out, int out_size, void* d_ws,
                              size_t ws_size, hipStream_t stream) {
  Params p{};
  p.x = (const float*)d_in[0]; p.c = (const float*)d_in[1]; p.ctx = (const float*)d_in[2]; p.c_ctx = (const float*)d_in[3];
  p.w_mod = (const float*)d_in[4]; p.b_mod = (const float*)d_in[5]; p.norm_attn = (const float*)d_in[6];
  p.norm_ffn = (const float*)d_in[7]; p.w_in = (const float*)d_in[8]; p.qk_norm = (const float*)d_in[9];
  p.sink = (const float*)d_in[10]; p.rpb = (const float*)d_in[11]; p.w_out = (const float*)d_in[12];
  p.w_gate = (const float*)d_in[13]; p.w_up = (const float*)d_in[14]; p.w_down = (const float*)d_in[15];
  p.out = (float*)d_out;
  char* w = (char*)d_ws;
  size_t off = 0;
  auto take = [&](size_t bytes) { char* r = w + off; off += (bytes + 255) & ~(size_t)255; return r; };
  p.counters = (unsigned*)take(4096 + XCD_BAR_WORDS * 4);
  p.wt_in = (u16*)take((size_t)NLAYER * INW * LDK * 2);
  p.wt_out = (u16*)take((size_t)NLAYER * DM * LDK * 2);
  p.wt_gu = (u16*)take((size_t)NLAYER * GUW * LDK * 2);
  p.wt_down = (u16*)take((size_t)NLAYER * DM * LDF * 2);
  p.H = (u16*)take((size_t)TTOT * LDK * 2);
  p.mod = (float*)take((size_t)NLAYER * 5 * 6144 * 4);
  p.xctx = (float*)take((size_t)TCTX * DM * 4);
  p.rope = (float*)take((size_t)SEQL * 32 * 2 * 4);
  p.bounds = (float*)take(256);
  p.QKV = (u16*)take((size_t)NBATCH * 32 * LTOT * 64 * 2);
  p.O = (u16*)take((size_t)TTOT * LDK * 2);
  p.ACT = p.QKV;

  hipMemsetAsync(p.counters, 0, 4096 + XCD_BAR_WORDS * 4, stream);

  static int grid_blocks = 0;
  if (!grid_blocks) {
    int dev = 0, cus = 0, per_cu = 0;
    hipGetDevice(&dev);
    hipDeviceGetAttribute(&cus, hipDeviceAttributeMultiprocessorCount, dev);
    hipFuncSetAttribute((const void*)fwd_megakernel, hipFuncAttributeMaxDynamicSharedMemorySize, DYN_LDS);
    hipOccupancyMaxActiveBlocksPerMultiprocessor(&per_cu, fwd_megakernel, NTHR, DYN_LDS);
    if (per_cu > 1) per_cu = 1;
    if (per_cu < 1) per_cu = 1;
    grid_blocks = cus * per_cu;
  }
  void* args[] = {&p};
  hipError_t e = hipLaunchCooperativeKernel((void*)fwd_megakernel, dim3(grid_blocks), dim3(NTHR), args, DYN_LDS, stream);
  if (e != hipSuccess) fprintf(stderr, "cooperative launch failed: %s (grid %d)\n", hipGetErrorString(e), grid_blocks);
}
```

```cpp
#include <hip/hip_runtime.h>
#include <hip/hip_cooperative_groups.h>
#include <cstdio>
namespace cg = cooperative_groups;

typedef unsigned short u16;
typedef __attribute__((ext_vector_type(8))) short bf16x8;
typedef __attribute__((ext_vector_type(16))) float f32x16;
typedef __attribute__((ext_vector_type(4))) float f32x4;
typedef __attribute__((ext_vector_type(2))) float f32x2;
typedef __attribute__((ext_vector_type(2))) __bf16 bf16x2_t;
#define DI __device__ __forceinline__
#define LAS __attribute__((address_space(3)))
#define MFMA32(a, b, c) __builtin_amdgcn_mfma_f32_32x32x16_bf16((a), (b), (c), 0, 0, 0)

constexpr int DM = 1024, NBATCH = 4, SEQL = 4096, CTXL = 256, LTOT = 4352;
constexpr int TLAT = NBATCH * SEQL, TCTX = NBATCH * CTXL, TTOT = TLAT + TCTX;
constexpr int NLAYER = 4, INW = 2048, FFN = 2816, GUW = 2 * FFN;
constexpr int LDK = DM, LDF = FFN;
constexpr int NTHR = 512;
constexpr int DYN_LDS = 131072 + 64;
constexpr float EPSV = 1e-6f;
constexpr float LOG2E = 1.4426950408889634f;

struct Params {
  const float *x, *c, *ctx, *c_ctx, *w_mod, *b_mod, *norm_attn, *norm_ffn, *w_in, *qk_norm, *sink, *rpb,
              *w_out, *w_gate, *w_up, *w_down;
  float* out;
  u16 *wt_in, *wt_out, *wt_gu, *wt_down, *H, *QKV, *O, *ACT;
  float *mod, *xctx, *rope, *bounds;
  unsigned* counters;
};

DI unsigned pack_bf16(float a, float b) {
  f32x2 v = {a, b};
  bf16x2_t r = __builtin_convertvector(v, bf16x2_t);
  return __builtin_bit_cast(unsigned, r);
}
DI u16 f2bf(float a) { return (u16)(pack_bf16(a, 0.f) & 0xffffu); }
DI int tidx() { int t = threadIdx.x; asm volatile("" : "+v"(t)); return t; }
DI int crow(int r, int h) { return (r & 3) + 8 * (r >> 2) + 4 * h; }

DI int grab(unsigned* ctr) {
  __shared__ int s_grab;
  if (threadIdx.x == 0) s_grab = (int)atomicAdd(ctr, 1u);
  __syncthreads();
  int v = s_grab;
  __syncthreads();
  return v;
}

DI void phase0(const Params& p, char* smem) {
  const int tid = tidx();
  constexpr int NWP = NLAYER * 2880 / 2, NMOD = NLAYER * 96, NROPE = 256, NBND = 1;
  const float* w_in_ = p.w_in; const float* w_out_ = p.w_out; const float* w_gate_ = p.w_gate;
  const float* w_up_ = p.w_up; const float* w_down_ = p.w_down;
  asm volatile("" : "+v"(w_in_), "+v"(w_out_), "+v"(w_gate_), "+v"(w_up_), "+v"(w_down_));
  for (int item = blockIdx.x; item < NWP + NMOD + NROPE + NBND; item += gridDim.x) {
    if (item < NWP) {
      const int half = tid >> 8, t = tid & 255;
      const int it2 = item * 2 + half;
      const int layer = it2 / 2880; int idx = it2 % 2880;
      const float* src; int N, k0, n0, Kd, up = 0, kind;
      u16* dst;
      if (idx < 512) { kind = 0; k0 = (idx >> 5) * 64; n0 = (idx & 31) * 64; src = w_in_ + (size_t)layer * DM * INW; N = INW; dst = p.wt_in + (size_t)layer * INW * DM; Kd = DM; }
      else if (idx < 768) { idx -= 512; kind = 0; k0 = (idx >> 4) * 64; n0 = (idx & 15) * 64; src = w_out_ + (size_t)layer * DM * DM; N = DM; dst = p.wt_out + (size_t)layer * DM * DM; Kd = DM; }
      else if (idx < 2176) { idx -= 768; up = idx >= 704; if (up) idx -= 704; kind = 1; k0 = (idx / 44) * 64; n0 = (idx % 44) * 64;
        src = (up ? w_up_ : w_gate_) + (size_t)layer * DM * FFN; N = FFN; dst = p.wt_gu + (size_t)layer * GUW * DM; Kd = DM; }
      else { idx -= 2176; kind = 0; k0 = (idx >> 4) * 64; n0 = (idx & 15) * 64; src = w_down_ + (size_t)layer * FFN * DM; N = DM; dst = p.wt_down + (size_t)layer * DM * FFN; Kd = FFN; }
      float* tile = (float*)(smem + half * 16640);
#pragma unroll
      for (int ps = 0; ps < 4; ++ps) {
        int kk = (t >> 4) + 16 * ps, nn = (t & 15) * 4;
        float4 v = *(const float4*)(src + (size_t)(k0 + kk) * N + n0 + nn);
        tile[kk * 65 + nn] = v.x; tile[kk * 65 + nn + 1] = v.y; tile[kk * 65 + nn + 2] = v.z; tile[kk * 65 + nn + 3] = v.w;
      }
      __syncthreads();
      {
        int n = t >> 2, kc = (t & 3) * 16;
        unsigned w[8];
#pragma unroll
        for (int j = 0; j < 8; ++j) w[j] = pack_bf16(tile[(kc + 2 * j) * 65 + n], tile[(kc + 2 * j + 1) * 65 + n]);
        int col = n0 + n;
        int row = kind ? ((col >> 7) * 256 + up * 128 + (col & 127)) : col;
        uint4* d = (uint4*)(dst + (size_t)row * Kd + k0 + kc);
        d[0] = make_uint4(w[0], w[1], w[2], w[3]);
        d[1] = make_uint4(w[4], w[5], w[6], w[7]);
      }
      __syncthreads();
    } else if (item < NWP + NMOD) {
      int it = item - NWP, layer = it / 96, cg0 = (it % 96) * 64;
      float* sc = (float*)smem;
      float* red = sc + 5 * 1024;
      for (int e = tid; e < 5 * 1024; e += NTHR) {
        int mb = e >> 10, k = e & 1023;
        float v = (mb < 4) ? p.c[mb * 1024 + k] : p.c_ctx[k];
        sc[e] = v / (1.f + __expf(-v));
      }
      __syncthreads();
      int col = cg0 + (tid & 63), kq = tid >> 6;
      const float* w = p.w_mod + (size_t)layer * DM * 6144 + col;
      float a0 = 0, a1 = 0, a2 = 0, a3 = 0, a4 = 0;
#pragma unroll 8
      for (int k = kq * 128; k < kq * 128 + 128; ++k) {
        float wv = w[(size_t)k * 6144];
        a0 += sc[k] * wv; a1 += sc[1024 + k] * wv; a2 += sc[2048 + k] * wv; a3 += sc[3072 + k] * wv; a4 += sc[4096 + k] * wv;
      }
      int c64 = tid & 63;
      red[(kq * 5 + 0) * 64 + c64] = a0; red[(kq * 5 + 1) * 64 + c64] = a1; red[(kq * 5 + 2) * 64 + c64] = a2;
      red[(kq * 5 + 3) * 64 + c64] = a3; red[(kq * 5 + 4) * 64 + c64] = a4;
      __syncthreads();
      for (int e = tid; e < 5 * 64; e += NTHR) {
        int mb = e >> 6, cc = e & 63;
        float s = 0.f;
#pragma unroll
        for (int q = 0; q < 8; ++q) s += red[(q * 5 + mb) * 64 + cc];
        p.mod[((size_t)layer * 5 + mb) * 6144 + cg0 + cc] = s + p.b_mod[layer * 6144 + cg0 + cc];
      }
      __syncthreads();
    } else if (item >= NWP + NMOD + NROPE) {
      unsigned* mx = (unsigned*)smem;
      for (int e = tid; e < NLAYER * 10; e += NTHR) mx[e] = 0u;
      __syncthreads();
      for (int e = tid; e < NLAYER * 6 * 64; e += NTHR) atomicMax(&mx[(e / 384) * 10 + (e % 384) / 64], __float_as_uint(fabsf(p.qk_norm[e])));
      for (int e = tid; e < NLAYER * 4 * 465; e += NTHR) atomicMax(&mx[(e / 1860) * 10 + 6 + (e % 1860) / 465], __float_as_uint(fabsf(p.rpb[e])));
      __syncthreads();
      if (tid < NLAYER * 8) {
        int l = tid >> 3, j = tid & 7; float v = 0.f;
        if (j < 3) v = 0.125f * LOG2E * 64.f * 1.02f * __uint_as_float(mx[l * 10 + 2 * j]) * __uint_as_float(mx[l * 10 + 2 * j + 1]);
        else if (j >= 4) v = LOG2E * __uint_as_float(mx[l * 10 + 6 + (j - 4)]);
        p.bounds[tid] = v;
      }
      __syncthreads();
    } else {
      int e = (item - NWP - NMOD) * NTHR + tid;
      int t = e >> 5, pi = e & 31;
      float pos = (pi < 16) ? (float)(t >> 6) : (float)(t & 63);
      float inv = exp2f(-(float)(pi & 15) * (13.287712379549449f / 16.0f));
      float ang = pos * inv;
      p.rope[2 * e] = __cosf(ang);
      p.rope[2 * e + 1] = __sinf(ang);
    }
  }
}

DI const float* xrow_src(const Params& p, int layer, int t) {
  const float* a = p.x; const float* b = p.out; const float* c = p.ctx; const float* d = p.xctx;
  asm volatile("" : "+v"(a), "+v"(b), "+v"(c), "+v"(d));
  if (t < TLAT) return (layer == 0 ? a : b) + (size_t)t * DM;
  return (layer == 0 ? c : d) + (size_t)(t - TLAT) * DM;
}
DI float* xrow_dst(const Params& p, int t) {
  float* b = p.out; float* d = p.xctx;
  asm volatile("" : "+v"(b), "+v"(d));
  if (t < TLAT) return b + (size_t)t * DM;
  return d + (size_t)(t - TLAT) * DM;
}
DI int mb_of(int t) { return t < TLAT ? (t >> 12) : 4; }

DI void norm_row(const Params& p, int layer, int which, int t, int lane) {
  const float* g = (which ? p.norm_ffn : p.norm_attn) + layer * DM;
  const float* xr = which ? (const float*)xrow_dst(p, t) : xrow_src(p, layer, t);
  const float* md = p.mod + ((size_t)layer * 5 + mb_of(t)) * 6144 + (which ? 3 * 1024 : 0);
  float4 v[4];
  float ss = 0.f;
#pragma unroll
  for (int j = 0; j < 4; ++j) {
    v[j] = *(const float4*)(xr + lane * 4 + 256 * j);
    ss += v[j].x * v[j].x + v[j].y * v[j].y + v[j].z * v[j].z + v[j].w * v[j].w;
  }
#pragma unroll
  for (int o = 32; o >= 1; o >>= 1) ss += __shfl_xor(ss, o);
  float r = rsqrtf(ss * (1.f / 1024.f) + EPSV);
#pragma unroll
  for (int j = 0; j < 4; ++j) {
    int col = lane * 4 + 256 * j;
    float4 gg = *(const float4*)(g + col);
    float4 sh = *(const float4*)(md + col);
    float4 sc = *(const float4*)(md + 1024 + col);
    float o0 = v[j].x * r * gg.x * (1.f + sc.x) + sh.x;
    float o1 = v[j].y * r * gg.y * (1.f + sc.y) + sh.y;
    float o2 = v[j].z * r * gg.z * (1.f + sc.z) + sh.z;
    float o3 = v[j].w * r * gg.w * (1.f + sc.w) + sh.w;
    *(uint2*)(p.H + (size_t)t * LDK + col) = make_uint2(pack_bf16(o0, o1), pack_bf16(o2, o3));
  }
}
DI void norm_row2(const Params& p, int layer, int which, int ta, int tb, int lane) {
  const float* g = (which ? p.norm_ffn : p.norm_attn) + layer * DM;
  const float* xa = which ? (const float*)xrow_dst(p, ta) : xrow_src(p, layer, ta);
  const float* xb = which ? (const float*)xrow_dst(p, tb) : xrow_src(p, layer, tb);
  const float* md = p.mod + ((size_t)layer * 5 + mb_of(ta)) * 6144 + (which ? 3 * 1024 : 0);
  float4 va[4], vb[4];
  float sa = 0.f, sb = 0.f;
#pragma unroll
  for (int j = 0; j < 4; ++j) { va[j] = *(const float4*)(xa + lane * 4 + 256 * j); vb[j] = *(const float4*)(xb + lane * 4 + 256 * j); }
#pragma unroll
  for (int j = 0; j < 4; ++j) {
    sa += va[j].x * va[j].x + va[j].y * va[j].y + va[j].z * va[j].z + va[j].w * va[j].w;
    sb += vb[j].x * vb[j].x + vb[j].y * vb[j].y + vb[j].z * vb[j].z + vb[j].w * vb[j].w;
  }
#pragma unroll
  for (int o = 32; o >= 1; o >>= 1) { sa += __shfl_xor(sa, o); sb += __shfl_xor(sb, o); }
  const float ra = rsqrtf(sa * (1.f / 1024.f) + EPSV), rb = rsqrtf(sb * (1.f / 1024.f) + EPSV);
#pragma unroll
  for (int j = 0; j < 4; ++j) {
    int col = lane * 4 + 256 * j;
    float4 gg = *(const float4*)(g + col);
    float4 sh = *(const float4*)(md + col);
    float4 sc = *(const float4*)(md + 1024 + col);
    float m0 = gg.x * (1.f + sc.x), m1 = gg.y * (1.f + sc.y), m2 = gg.z * (1.f + sc.z), m3 = gg.w * (1.f + sc.w);
    *(uint2*)(p.H + (size_t)ta * LDK + col) = make_uint2(pack_bf16(va[j].x * ra * m0 + sh.x, va[j].y * ra * m1 + sh.y), pack_bf16(va[j].z * ra * m2 + sh.z, va[j].w * ra * m3 + sh.w));
    *(uint2*)(p.H + (size_t)tb * LDK + col) = make_uint2(pack_bf16(vb[j].x * rb * m0 + sh.x, vb[j].y * rb * m1 + sh.y), pack_bf16(vb[j].z * rb * m2 + sh.z, vb[j].w * rb * m3 + sh.w));
  }
}
DI void norm_static(const Params& p, int layer, int which, int row0, int row1) {
  const int tid = tidx(), lane = tid & 63, wid = tid >> 6;
  for (int t = row0 + blockIdx.x * 8 + wid; t < row1; t += gridDim.x * 8) norm_row(p, layer, which, t, lane);
}
DI void norm_dyn(const Params& p, int layer, int which, int row0, int row1, unsigned* ctr) {
  const int tid = tidx(), lane = tid & 63, wid = tid >> 6;
  const int nchunk = (row1 - row0) >> 5;
  while (true) {
    int ch = grab(ctr);
    if (ch >= nchunk) break;
#pragma unroll 1
    for (int q = 0; q < 4; q += 2) norm_row2(p, layer, which, row0 + ch * 32 + q * 8 + wid, row0 + ch * 32 + (q + 1) * 8 + wid, lane);
  }
}

namespace pg8 {
typedef unsigned short bf16_t;
constexpr int BM = 256, BK = 64, HALF = 128, HTB = HALF * BK * 2, STAGE_BYTES = 8 * HTB, NXCD = 8, WGM = 8;
DI int lds_byte(int r, int c) { const int st = (r >> 4) * 2 + (c >> 5), rr = r & 15, cc = c & 31, ob = rr * 64 + cc * 2; return st * 1024 + (ob ^ (((ob >> 9) & 1) << 5)); }
DI void stage_rc(int b, int& R, int& C) { const int st = b / 1024, sb = b % 1024, swz = sb ^ (((sb >> 9) & 1) << 5); R = (st >> 1) * 16 + swz / 64; C = (st & 1) * 32 + (swz % 64) / 2; }
DI int perm32(int rho) { const int n = rho >> 4, i = rho & 15; return 8 * (i >> 2) + 4 * n + (i & 3); }
struct Unit { int pm, pn; };
struct Gemm { const bf16_t* A; const bf16_t* Bt; int K; };

struct TileOrder {
  int nM, nN, nwg, G, c, remap;
  DI void init(int nM_, int nN_, int G_, int c_, int remap_) { nM = nM_; nN = nN_; nwg = nM * nN; G = G_; c = c_; remap = remap_; }
  DI bool next(int i, Unit& u) const {
    long L = (long)i * G + c;
    if (remap) {
      if (c >= 240) { if (i >= 3) return false; }
      else if (c >= 128 && c < 144 && i == 5) L = 4L * G + (c + 112);
      else if (c >= 144 && c < 160 && i == 5) L = 3L * G + (c + 96);
    }
    if (L >= nwg) return false;
    int wgid = (int)L; { const int q = nwg / NXCD, r = nwg % NXCD, xcd = wgid % NXCD, off = wgid / NXCD; wgid = (xcd < r ? xcd * (q + 1) : r * (q + 1) + (xcd - r) * q) + off; }
    const int nig = WGM * nN, gid = wgid / nig, fm = gid * WGM, gsz = (nM - fm) < WGM ? (nM - fm) : WGM;
    u.pm = fm + ((wgid % nig) % gsz); u.pn = (wgid % nig) / gsz; return true;
  }
};
struct OneUnit {
  Unit u; bool valid;
  DI bool next(int i, Unit& o) const { if (i != 0 || !valid) return false; o = u; return true; }
};

template <class Epi, class Sched>
DI void gemm_phase(LAS unsigned char* lds, const Gemm g, const Sched& S, const Epi& E) {
  const int tid = tidx(), wid = __builtin_amdgcn_readfirstlane(tid >> 6), lane = tid & 63, wr = wid >> 2, wc = wid & 3, fr = lane & 15, fq = lane >> 4;
  int K = g.K; asm volatile("" : "+s"(K));
  const int nt = K / BK;
  unsigned voffA[2], voffB[2];
#pragma unroll
  for (int i = 0; i < 2; ++i) {
    int R, C; stage_rc(tid * 16 + i * 8192, R, C);
    int Rb = R;
    if (Epi::BMAP == 1) Rb = (R & ~31) + perm32(R & 31);
    if (Epi::BMAP == 2) Rb = 64 * (R >> 5) + perm32(R & 31);
    voffA[i] = (unsigned)(R * K + C) * 2u; voffB[i] = (unsigned)(Rb * K + C) * 2u;
  }
  const size_t kstep = (size_t)(BK * 2);
  const size_t hstep = (size_t)HALF * K * 2;
  const size_t hstepB = (Epi::BMAP == 2) ? (size_t)32 * K * 2 : hstep;
  const size_t tstep = 2 * hstep;
  const unsigned ldsw = (unsigned)wid * 1024u;
  const int aoff = lds_byte(wr * 64 + fr, fq * 8), boff = lds_byte(wc * 32 + fr, fq * 8);
#define PG8_SA(b, h) (((b) * 2 + (h)) * HTB)
#define PG8_SB(b, h) ((4 + (b) * 2 + (h)) * HTB)
#define PG8_STAGE(bufoff, gbase, voff) do { _Pragma("unroll") for (int _i = 0; _i < 2; ++_i) \
    __builtin_amdgcn_global_load_lds((const unsigned*)((const char*)(gbase) + (voff)[_i]), (LAS unsigned*)(lds + (bufoff) + ldsw + _i * 8192), 16, 0, 0); } while (0)
#define PG8_LDA(dst, b, h) do { _Pragma("unroll") for (int m = 0; m < 4; ++m) _Pragma("unroll") for (int k = 0; k < 2; ++k) dst[m][k] = *(const LAS bf16x8*)(lds + PG8_SA(b, h) + aoff + m * 2048 + k * 1024); } while (0)
#define PG8_LDB(dst, b, h) do { _Pragma("unroll") for (int n = 0; n < 2; ++n) _Pragma("unroll") for (int k = 0; k < 2; ++k) dst[n][k] = *(const LAS bf16x8*)(lds + PG8_SB(b, h) + boff + n * 2048 + k * 1024); } while (0)
#define PG8_MMA(ai, bj, At, Bt) do { __builtin_amdgcn_s_setprio(1); _Pragma("unroll") for (int m = 0; m < 4; ++m) _Pragma("unroll") for (int n = 0; n < 2; ++n) _Pragma("unroll") for (int k = 0; k < 2; ++k) \
    acc[ai][bj][m][n] = __builtin_amdgcn_mfma_f32_16x16x32_bf16(Bt[n][k], At[m][k], acc[ai][bj][m][n], 0, 0, 0); __builtin_amdgcn_s_setprio(0); } while (0)
#define PG8_WAIT_V(n) asm volatile("s_waitcnt vmcnt(" #n ")" ::: "memory")
#define PG8_WAIT_L(n) asm volatile("s_waitcnt lgkmcnt(" #n ")" ::: "memory")
#define PG8_BAR __builtin_amdgcn_s_barrier()
#define PG8_SCHED __builtin_amdgcn_sched_barrier(0)
  Unit cur, nxt; int ui = 0;
  if (!S.next(0, cur)) return;
  f32x4 acc[2][2][4][2];
#pragma unroll
  for (int a = 0; a < 2; ++a)
#pragma unroll
    for (int b = 0; b < 2; ++b)
#pragma unroll
      for (int m = 0; m < 4; ++m)
#pragma unroll
        for (int n = 0; n < 2; ++n) acc[a][b][m][n] = (f32x4){0.f, 0.f, 0.f, 0.f};
  bf16x8 At[4][2], B0[2][2], B1[2][2];
  const char* cA = (const char*)g.A + (size_t)cur.pm * tstep; const char* cB = (const char*)g.Bt + (size_t)cur.pn * tstep;
  PG8_STAGE(PG8_SB(0, 0), cB, voffB); PG8_STAGE(PG8_SA(0, 0), cA, voffA); PG8_STAGE(PG8_SB(0, 1), cB + hstepB, voffB); PG8_STAGE(PG8_SA(0, 1), cA + hstep, voffA);
  if (wr == 1) PG8_BAR;
  PG8_WAIT_V(4); PG8_BAR;
  PG8_STAGE(PG8_SB(1, 0), cB + kstep, voffB); PG8_STAGE(PG8_SA(1, 0), cA + kstep, voffA); PG8_STAGE(PG8_SB(1, 1), cB + hstepB + kstep, voffB);
  PG8_WAIT_V(6); PG8_BAR;
  for (;;) {
    const bool has_next = S.next(ui + 1, nxt);
    const char* nA = has_next ? (const char*)g.A + (size_t)nxt.pm * tstep : cA; const char* nB = has_next ? (const char*)g.Bt + (size_t)nxt.pn * tstep : cB;
    for (int t = 0; t < nt; t += 2) {
      const bool last = (t == nt - 2);
      const char* a1 = cA + (size_t)(t + 1) * kstep;
      const char* a2 = last ? nA : cA + (size_t)(t + 2) * kstep; const char* b2 = last ? nB : cB + (size_t)(t + 2) * kstep;
      const char* a3 = a2 + kstep; const char* b3 = b2 + kstep;
      PG8_LDB(B0, 0, 0); PG8_SCHED; PG8_LDA(At, 0, 0); PG8_STAGE(PG8_SA(1, 1), a1 + hstep, voffA);
      PG8_WAIT_L(8); PG8_BAR; PG8_WAIT_L(0); PG8_MMA(0, 0, At, B0); PG8_BAR; PG8_SCHED;
      PG8_LDB(B1, 0, 1); PG8_STAGE(PG8_SB(0, 0), b2, voffB);
      PG8_BAR; PG8_WAIT_L(0); PG8_MMA(0, 1, At, B1); PG8_BAR;
      PG8_LDA(At, 0, 1); PG8_STAGE(PG8_SA(0, 0), a2, voffA);
      PG8_BAR; PG8_WAIT_L(0); PG8_MMA(1, 0, At, B0); PG8_BAR; PG8_SCHED;
      PG8_STAGE(PG8_SB(0, 1), b2 + hstepB, voffB);
      PG8_WAIT_V(6); PG8_BAR; PG8_MMA(1, 1, At, B1); PG8_BAR;
      PG8_LDB(B0, 1, 0); PG8_SCHED; PG8_LDA(At, 1, 0); PG8_STAGE(PG8_SA(0, 1), a2 + hstep, voffA);
      PG8_WAIT_L(8); PG8_BAR; PG8_WAIT_L(0); PG8_MMA(0, 0, At, B0); PG8_BAR; PG8_SCHED;
      PG8_LDB(B1, 1, 1); PG8_STAGE(PG8_SB(1, 0), b3, voffB);
      PG8_BAR; PG8_WAIT_L(0); PG8_MMA(0, 1, At, B1); PG8_BAR;
      PG8_LDA(At, 1, 1); PG8_STAGE(PG8_SA(1, 0), a3, voffA);
      PG8_BAR; PG8_WAIT_L(0); PG8_MMA(1, 0, At, B0); PG8_BAR; PG8_SCHED;
      PG8_STAGE(PG8_SB(1, 1), b3 + hstepB, voffB);
      PG8_WAIT_V(6); PG8_BAR; PG8_MMA(1, 1, At, B1); PG8_BAR;
    }
    E(acc, cur, wr, wc, fr, fq);
    if (!has_next) break;
#pragma unroll
    for (int a = 0; a < 2; ++a)
#pragma unroll
      for (int b = 0; b < 2; ++b)
#pragma unroll
        for (int m = 0; m < 4; ++m)
#pragma unroll
          for (int n = 0; n < 2; ++n) acc[a][b][m][n] = (f32x4){0.f, 0.f, 0.f, 0.f};
    cur = nxt; cA = nA; cB = nB; ++ui;
  }
  PG8_WAIT_V(0);
  if (wr == 0) PG8_BAR;
  PG8_BAR;
#undef PG8_SA
#undef PG8_SB
#undef PG8_STAGE
#undef PG8_LDA
#undef PG8_LDB
#undef PG8_MMA
#undef PG8_WAIT_V
#undef PG8_WAIT_L
#undef PG8_BAR
#undef PG8_SCHED
}

struct EpiRes {
  static constexpr int BMAP = 0;
  const float* src; float* dst; const float* gate;
  DI void operator()(const f32x4 (&acc)[2][2][4][2], const Unit& u, int wr, int wc, int fr, int fq) const {
    asm volatile("" ::: "memory");
    const int row0 = u.pm * BM + wr * 64 + fr, col0 = u.pn * BM + wc * 32 + 4 * fq;
    f32x4 gv[2][2];
#pragma unroll
    for (int bj = 0; bj < 2; ++bj)
#pragma unroll
      for (int n = 0; n < 2; ++n) gv[bj][n] = *(const f32x4*)(gate + col0 + bj * HALF + n * 16);
#pragma unroll
    for (int ai = 0; ai < 2; ++ai)
#pragma unroll
      for (int m = 0; m < 4; ++m) {
        const size_t ro = (size_t)(row0 + ai * HALF + m * 16) * DM + col0;
#pragma unroll
        for (int bj = 0; bj < 2; ++bj)
#pragma unroll
          for (int n = 0; n < 2; ++n) {
            f32x4 s = *(const f32x4*)(src + ro + bj * HALF + n * 16);
            *(f32x4*)(dst + ro + bj * HALF + n * 16) = s + gv[bj][n] * acc[ai][bj][m][n];
          }
      }
  }
};
struct EpiGU {
  static constexpr int BMAP = 1;
  u16* act;
  DI void operator()(const f32x4 (&acc)[2][2][4][2], const Unit& u, int wr, int wc, int fr, int fq) const {
    asm volatile("" ::: "memory");
    const int row0 = u.pm * BM + wr * 64 + fr, col0 = u.pn * HALF + wc * 32 + 8 * fq;
#pragma unroll
    for (int ai = 0; ai < 2; ++ai)
#pragma unroll
      for (int m = 0; m < 4; ++m) {
        float a[8];
#pragma unroll
        for (int n = 0; n < 2; ++n)
#pragma unroll
          for (int e = 0; e < 4; ++e) {
            float gte = acc[ai][0][m][n][e], up = acc[ai][1][m][n][e];
            a[n * 4 + e] = gte * __builtin_amdgcn_rcpf(1.f + __builtin_amdgcn_exp2f(-gte * LOG2E)) * up;
          }
        *(uint4*)(act + (size_t)(row0 + ai * HALF + m * 16) * FFN + col0) =
            make_uint4(pack_bf16(a[0], a[1]), pack_bf16(a[2], a[3]), pack_bf16(a[4], a[5]), pack_bf16(a[6], a[7]));
      }
  }
};
struct EpiQKV {
  static constexpr int BMAP = 2;
  u16* qkv; const float* qkn; const float* rope; int rowbase;
  DI void operator()(const f32x4 (&acc)[2][2][4][2], const Unit& u, int wr, int wc, int fr, int fq) const {
    asm volatile("" ::: "memory");
    const int chunk = u.pn * 4 + wc;
    const bool isV = (chunk == 8 || chunk == 9 || (chunk >= 18 && chunk <= 21) || chunk >= 30);
    int gi = 0;
    if (chunk < 6) gi = 0; else if (chunk < 8) gi = 1; else if (chunk < 14) gi = 2; else if (chunk < 18) gi = 3;
    else if (chunk < 28) gi = 4; else gi = 5;
    const bool ropeT = (gi == 0 || gi == 1 || gi == 4 || gi == 5) && rowbase == 0;
    const float* gam = qkn + gi * 64;
    const float qs = (gi == 0 || gi == 2 || gi == 4) ? 0.125f * LOG2E : 1.f;
    f32x4 g4[2][2];
#pragma unroll
    for (int bj = 0; bj < 2; ++bj)
#pragma unroll
      for (int n = 0; n < 2; ++n) g4[bj][n] = *(const f32x4*)(gam + 32 * bj + 8 * fq + 4 * n);
#pragma unroll
    for (int ai = 0; ai < 2; ++ai)
#pragma unroll
      for (int m = 0; m < 4; ++m) {
        const int t = u.pm * BM + ai * HALF + wr * 64 + m * 16 + fr;
        int b, pos;
        if (rowbase == 0) { b = t >> 12; pos = t & 4095; } else { b = t >> 8; pos = 4096 + (t & 255); }
        u16* base = qkv + (size_t)(b * 32 + chunk) * LTOT * 64;
        if (isV) {
#pragma unroll
          for (int bj = 0; bj < 2; ++bj)
#pragma unroll
            for (int n = 0; n < 2; ++n)
#pragma unroll
              for (int e = 0; e < 4; ++e) {
                int d = 32 * bj + 8 * fq + 4 * n + e;
                base[(size_t)d * LTOT + pos] = f2bf(acc[ai][bj][m][n][e]);
              }
        } else {
          float ss = 0.f;
#pragma unroll
          for (int bj = 0; bj < 2; ++bj)
#pragma unroll
            for (int n = 0; n < 2; ++n)
#pragma unroll
              for (int e = 0; e < 4; ++e) ss += acc[ai][bj][m][n][e] * acc[ai][bj][m][n][e];
          ss += __shfl_xor(ss, 16);
          ss += __shfl_xor(ss, 32);
          const float rinv = rsqrtf(ss * (1.f / 64.f) + EPSV);
          float o1[8], o2[8];
#pragma unroll
          for (int n = 0; n < 2; ++n) {
            f32x4 cs0 = (f32x4){1.f, 0.f, 1.f, 0.f}, cs1 = cs0;
            if (ropeT) { const float* rp = rope + (size_t)pos * 64 + 2 * (8 * fq + 4 * n); cs0 = *(const f32x4*)rp; cs1 = *(const f32x4*)(rp + 4); }
#pragma unroll
            for (int e = 0; e < 4; ++e) {
              float x1 = acc[ai][0][m][n][e] * (rinv * qs) * g4[0][n][e];
              float x2 = acc[ai][1][m][n][e] * (rinv * qs) * g4[1][n][e];
              float c = (e < 2) ? cs0[2 * e] : cs1[2 * (e - 2)], s = (e < 2) ? cs0[2 * e + 1] : cs1[2 * (e - 2) + 1];
              o1[n * 4 + e] = x1 * c - x2 * s;
              o2[n * 4 + e] = x2 * c + x1 * s;
            }
          }
          u16* dst = base + (size_t)pos * 64 + 8 * fq;
          *(uint4*)(dst) = make_uint4(pack_bf16(o1[0], o1[1]), pack_bf16(o1[2], o1[3]), pack_bf16(o1[4], o1[5]), pack_bf16(o1[6], o1[7]));
          *(uint4*)(dst + 32) = make_uint4(pack_bf16(o2[0], o2[1]), pack_bf16(o2[2], o2[3]), pack_bf16(o2[4], o2[5]), pack_bf16(o2[6], o2[7]));
        }
      }
  }
};
}

constexpr int KROW = 144, VROW = 144;
constexpr int KT_B = 64 * KROW, VT_B = 64 * VROW, KV_B = KT_B + VT_B;
constexpr int RPB_OFF = 2 * KV_B;
constexpr int NAT_C = 384, NAT_B = 256, NAT_A = 384, NAT_LAT = NAT_C + NAT_B + NAT_A, NAT_CTX = 64;

DI void attn_item(const Params& p, int layer, int item, char* smem) {
  const int tid = tidx(), lane = tid & 63, wid = tid >> 6, l32 = lane & 31, h = lane >> 5;
  int mode, b, hh, qb;
  if (item < NAT_C) { mode = 0; b = item / 96; int rem = item % 96; hh = rem >> 4; qb = rem & 15; }
  else if (item < NAT_C + NAT_B) { int it = item - NAT_C; mode = 1; b = it >> 6; hh = (it & 63) >> 4; qb = it & 15; }
  else if (item < NAT_LAT) { int it = item - NAT_C - NAT_B; mode = 2; b = it / 96; int rem = it % 96; hh = rem >> 4; qb = rem & 15; }
  else { int it = item - NAT_LAT; mode = 3; b = it >> 4; hh = it & 15; qb = 0; }

  int qchunk, kchunk, vchunk, head16, t0 = 0, t1 = 0, qpos0 = qb * 256;
  bool hasSink = false; float sinkv = 0.f;
  int maskmode = 0;
  if (mode == 0) { qchunk = 22 + hh; kchunk = 28 + hh / 3; vchunk = 30 + hh / 3; head16 = 10 + hh; t0 = 0; t1 = 64; }
  else if (mode == 1) {
    qchunk = 10 + hh; kchunk = 14 + hh; vchunk = 18 + hh; head16 = 6 + hh; maskmode = 1;
    t0 = min(max(4 * qb - 4, 0), 56); t1 = min(max(4 * qb + 3 - 4, 0), 56) + 8;
  } else if (mode == 2) {
    qchunk = hh; kchunk = 6 + hh / 3; vchunk = 8 + hh / 3; head16 = hh; maskmode = 2;
    t0 = max(0, 4 * qb - 2); t1 = min(64, 4 * qb + 6); hasSink = true; sinkv = p.sink[layer * 6 + hh];
  } else {
    head16 = hh; qpos0 = 4096;
    if (hh < 6) { qchunk = hh; kchunk = 6 + hh / 3; vchunk = 8 + hh / 3; hasSink = true; sinkv = p.sink[layer * 6 + hh]; }
    else if (hh < 10) { int hb = hh - 6; qchunk = 10 + hb; kchunk = 14 + hb; vchunk = 18 + hb; }
    else { int hc = hh - 10; qchunk = 22 + hc; kchunk = 28 + hc / 3; vchunk = 30 + hc / 3; }
  }
  const int n_it = 4 + (t1 - t0);
  const u16* Qb = p.QKV + (size_t)(b * 32 + qchunk) * LTOT * 64;
  const u16* Kb = p.QKV + (size_t)(b * 32 + kchunk) * LTOT * 64;
  const u16* Vb = p.QKV + (size_t)(b * 32 + vchunk) * LTOT * 64;
  float* s_rpb = (float*)(smem + RPB_OFF);
  if (mode == 1) {
    const float* rp = p.rpb + (size_t)(layer * 4 + hh) * 465;
    for (int e = tid; e < 465; e += NTHR) s_rpb[e] = rp[e] * LOG2E;
  }

  const int qpos = qpos0 + wid * 32 + l32;
  bf16x8 qf[4];
#pragma unroll
  for (int s = 0; s < 4; ++s) qf[s] = *(const bf16x8*)(Qb + (size_t)qpos * 64 + s * 16 + h * 8);

  f32x16 o0, o1;
#pragma unroll
  for (int r = 0; r < 16; ++r) { o0[r] = 0.f; o1[r] = 0.f; }
  const int btype = (mode == 3) ? (hh < 6 ? 0 : (hh < 10 ? 1 : 2)) : (mode == 0 ? 2 : (mode == 1 ? 1 : 0));
  float m_fix = p.bounds[layer * 8 + btype];
  if (mode == 1) m_fix += p.bounds[layer * 8 + 4 + hh];
  f32x16 cinit, lacc;
#pragma unroll
  for (int r = 0; r < 16; ++r) { cinit[r] = -m_fix; lacc[r] = 0.f; }
  const bf16x8 ones = {(short)0x3F80, (short)0x3F80, (short)0x3F80, (short)0x3F80, (short)0x3F80, (short)0x3F80, (short)0x3F80, (short)0x3F80};

  const int lr = tid >> 3, lc = tid & 7;
  uint4 ka0, va0, kb0, vb0;
#define TILE_OF(it) ((it) < 4 ? 64 + (it) : t0 + (it) - 4)
#define AGLOAD(K0, V0, tile)                                                           \
  {                                                                                    \
    K0 = *(const uint4*)(Kb + (size_t)((tile) * 64 + lr) * 64 + lc * 8);               \
    V0 = *(const uint4*)(Vb + (size_t)(lr) * LTOT + (tile) * 64 + lc * 8);             \
  }
#define ASWRITE(K0, V0, buf)                                                           \
  {                                                                                    \
    *(uint4*)(smem + (buf) * KV_B + (lr) * KROW + lc * 16) = K0;                       \
      \
                       \
    char* vd = smem + (buf) * KV_B + KT_B + (lr) * VROW + (16 * (lc >> 1) + 4 * (lc & 1)) * 2; \
    *(uint2*)(vd) = make_uint2(V0.x, V0.y);                                            \
    *(uint2*)(vd + 16) = make_uint2(V0.z, V0.w);                                       \
  }

  const int tq = qb * 256 + wid * 32 + l32;
  auto compute = [&](const int bufsel, const int tile) {
    bool skip = false;
    if (tile < 64) {
      if (maskmode == 1) {
        int qr = (qb * 256 + wid * 32) >> 6;
        int krw = min(max(qr - 4, 0), 56);
        skip = (tile < krw) || (tile >= krw + 8);
      } else if (maskmode == 2) {
        int q0w = qb * 256 + wid * 32, tk0 = tile * 64;
        skip = (tk0 > q0w + 31 + 128) || (tk0 + 63 < q0w - 128);
      }
    }
    if (!skip) {
      const char* sK = smem + bufsel * KV_B;
      const char* sV = sK + KT_B;
      f32x16 S[2];
      __builtin_amdgcn_s_setprio(1);
#pragma unroll
      for (int kt = 0; kt < 2; ++kt) {
#pragma unroll
        for (int s = 0; s < 4; ++s) {
          bf16x8 kf = *(const bf16x8*)(sK + (kt * 32 + l32) * KROW + s * 32 + h * 16);
          S[kt] = MFMA32(kf, qf[s], s == 0 ? cinit : S[kt]);
        }
      }
      __builtin_amdgcn_s_setprio(0);
      if (tile < 64 && maskmode == 1) {
        int qr = tq >> 6, qc = tq & 63;
        int ws = min(max(qc - 8, 0), 48);
        int dr = tile - qr + 7;
#pragma unroll
        for (int kt = 0; kt < 2; ++kt)
#pragma unroll
          for (int r = 0; r < 16; ++r) {
            int kc = kt * 32 + crow(r, h);
            bool ok = (unsigned)(kc - ws) < 16u;
            int bi = ok ? (dr * 31 + kc - qc + 15) : 0;
            float bv = s_rpb[bi];
            S[kt][r] = ok ? (S[kt][r] + bv) : -INFINITY;
          }
      } else if (tile < 64 && maskmode == 2) {
#pragma unroll
        for (int kt = 0; kt < 2; ++kt)
#pragma unroll
          for (int r = 0; r < 16; ++r) {
            int tk = tile * 64 + kt * 32 + crow(r, h);
            int dd = tq - tk;
            bool ok = (dd <= 128) && (dd >= -128);
            S[kt][r] = ok ? S[kt][r] : -INFINITY;
          }
      }
#pragma unroll
      for (int r = 0; r < 16; ++r) {
        S[0][r] = __builtin_amdgcn_exp2f(S[0][r]);
        S[1][r] = __builtin_amdgcn_exp2f(S[1][r]);
      }
#pragma unroll
      for (int kt = 0; kt < 2; ++kt)
#pragma unroll
        for (int s2 = 0; s2 < 2; ++s2) {
          uint4 pw;
          pw.x = pack_bf16(S[kt][8 * s2 + 0], S[kt][8 * s2 + 1]);
          pw.y = pack_bf16(S[kt][8 * s2 + 2], S[kt][8 * s2 + 3]);
          pw.z = pack_bf16(S[kt][8 * s2 + 4], S[kt][8 * s2 + 5]);
          pw.w = pack_bf16(S[kt][8 * s2 + 6], S[kt][8 * s2 + 7]);
          bf16x8 pf = __builtin_bit_cast(bf16x8, pw);
          const int koff = (kt * 32 + 16 * s2 + 8 * h) * 2;
          {
            bf16x8 vf = *(const bf16x8*)(sV + l32 * VROW + koff);
            o0 = MFMA32(vf, pf, o0);
            lacc = MFMA32(ones, pf, lacc);
          }
          {
            bf16x8 vf = *(const bf16x8*)(sV + (32 + l32) * VROW + koff);
            o1 = MFMA32(vf, pf, o1);
          }
        }
    }
  };

  AGLOAD(ka0, va0, TILE_OF(0));
  if (n_it > 1) { AGLOAD(kb0, vb0, TILE_OF(1)); }
  ASWRITE(ka0, va0, 0);
  if (n_it > 2) { AGLOAD(ka0, va0, TILE_OF(2)); }
  __syncthreads();
  for (int it = 0; it < n_it; it += 2) {
    if (it + 1 < n_it) { ASWRITE(kb0, vb0, 1); }
    if (it + 3 < n_it) { AGLOAD(kb0, vb0, TILE_OF(it + 3)); }
    __builtin_amdgcn_sched_barrier(0);
    compute(0, TILE_OF(it));
    __syncthreads();
    if (it + 1 < n_it) {
      if (it + 2 < n_it) { ASWRITE(ka0, va0, 0); }
      if (it + 4 < n_it) { AGLOAD(ka0, va0, TILE_OF(it + 4)); }
      __builtin_amdgcn_sched_barrier(0);
      compute(1, TILE_OF(it + 1));
      __syncthreads();
    }
  }
#undef AGLOAD
#undef ASWRITE
#undef TILE_OF

  float l_tot = lacc[0];
  if (hasSink) l_tot += __builtin_amdgcn_exp2f(sinkv * LOG2E - m_fix);
  float inv = 1.f / l_tot;
  int T = (mode == 3) ? (TLAT + b * 256 + (qpos - 4096)) : (b * 4096 + qpos);
  u16* od = p.O + (size_t)T * LDK + head16 * 64;
#pragma unroll
  for (int g = 0; g < 4; ++g) {
    int d0 = 8 * g + 4 * h;
    *(uint2*)(od + d0) = make_uint2(pack_bf16(o0[4 * g] * inv, o0[4 * g + 1] * inv), pack_bf16(o0[4 * g + 2] * inv, o0[4 * g + 3] * inv));
    *(uint2*)(od + 32 + d0) = make_uint2(pack_bf16(o1[4 * g] * inv, o1[4 * g + 1] * inv), pack_bf16(o1[4 * g + 2] * inv, o1[4 * g + 3] * inv));
  }
}

DI void run_gphase(const Params& p, int g, char* smem, int coff = 0) {
  using namespace pg8;
  LAS unsigned char* lds = (LAS unsigned char*)smem;
  const int layer = (g - 1) / 7, ph = (g - 1) % 7 + 1;
  const bool hasc = (g + 1 <= 23);
  const int cl = g / 7;
  const int bid = blockIdx.x, nb = gridDim.x;
  const float* xin_lat; const float* xin_ctx; float* xo_lat = p.out; float* xo_ctx = p.xctx;
  { const float* a_ = p.x; const float* c_ = p.ctx; asm volatile("" : "+s"(a_), "+s"(c_));
    float* b_ = p.out; float* d_ = p.xctx; asm volatile("" : "+s"(b_), "+s"(d_));
    xin_lat = (layer == 0) ? a_ : (const float*)b_; xin_ctx = (cl == 0) ? c_ : (const float*)d_; xo_lat = b_; xo_ctx = d_; }
  switch (ph) {
    case 1: {
      if (hasc) {
        OneUnit S; S.u.pm = bid & 3; S.u.pn = bid >> 2; S.valid = bid < 32;
        EpiQKV E; E.qkv = p.QKV; E.qkn = p.qk_norm + cl * 6 * 64; E.rope = p.rope; E.rowbase = TLAT;
        gemm_phase(lds, Gemm{p.H + (size_t)TLAT * LDK, p.wt_in + (size_t)cl * INW * LDK, DM}, S, E);
      }
      norm_dyn(p, layer, 0, 0, TLAT, &p.counters[32 + g + coff]);
    } break;
    case 2: {
      TileOrder S; S.init(64, 8, nb, bid, 0);
      EpiQKV E; E.qkv = p.QKV; E.qkn = p.qk_norm + layer * 6 * 64; E.rope = p.rope; E.rowbase = 0;
      gemm_phase(lds, Gemm{p.H, p.wt_in + (size_t)layer * INW * LDK, DM}, S, E);
      if (hasc)
        for (int i = bid; i < NAT_CTX; i += nb) attn_item(p, cl, NAT_LAT + i, smem);
    } break;
    case 3: {
      const int nctx = hasc ? 16 : 0;
      for (int it = grab(&p.counters[g + coff]); it < NAT_LAT + nctx; it = grab(&p.counters[g + coff])) {
        if (it < NAT_C) attn_item(p, layer, it, smem);
        else if (it < NAT_C + nctx) {
          int j = it - NAT_C;
          OneUnit S; S.u.pm = j & 3; S.u.pn = j >> 2; S.valid = true;
          EpiRes E; E.src = xin_ctx; E.dst = xo_ctx; E.gate = p.mod + ((size_t)cl * 5 + 4) * 6144 + 2 * 1024;
          gemm_phase(lds, Gemm{p.O + (size_t)TLAT * LDK, p.wt_out + (size_t)cl * DM * LDK, DM}, S, E);
        } else attn_item(p, layer, it - nctx, smem);
      }
    } break;
    case 4: {
      TileOrder S; S.init(64, 4, nb, bid, 0);
      Unit u0;
      for (int i = 0; S.next(i, u0); ++i) {
        OneUnit S1; S1.u = u0; S1.valid = true;
        EpiRes E; E.src = xin_lat; E.dst = xo_lat; E.gate = p.mod + ((size_t)layer * 5 + (u0.pm >> 4)) * 6144 + 2 * 1024;
        gemm_phase(lds, Gemm{p.O, p.wt_out + (size_t)layer * DM * LDK, DM}, S1, E);
      }
      if (hasc) norm_static(p, cl, 1, TLAT, TTOT);
    } break;
    case 5: {
      if (hasc) {
        OneUnit S; S.u.pm = bid & 3; S.u.pn = bid >> 2; S.valid = bid < 88;
        EpiGU E; E.act = p.ACT + (size_t)TLAT * LDF;
        gemm_phase(lds, Gemm{p.H + (size_t)TLAT * LDK, p.wt_gu + (size_t)cl * GUW * LDK, DM}, S, E);
      }
      norm_dyn(p, layer, 1, 0, TLAT, &p.counters[32 + g + coff]);
    } break;
    case 6: {
      if (hasc) {
        int j = (nb == 256) ? bid - 240 : bid;
        OneUnit S; S.u.pm = j & 3; S.u.pn = (j >> 2) & 3; S.valid = (j >= 0 && j < 16);
        EpiRes E; E.src = xo_ctx; E.dst = xo_ctx; E.gate = p.mod + ((size_t)cl * 5 + 4) * 6144 + 5 * 1024;
        gemm_phase(lds, Gemm{p.ACT + (size_t)TLAT * LDF, p.wt_down + (size_t)cl * DM * LDF, FFN}, S, E);
      }
      TileOrder S; S.init(64, 22, nb, bid, (hasc && nb == 256) ? 1 : 0);
      EpiGU E; E.act = p.ACT;
      gemm_phase(lds, Gemm{p.H, p.wt_gu + (size_t)layer * GUW * LDK, DM}, S, E);
    } break;
    case 7: {
      TileOrder S; S.init(64, 4, nb, bid, 0);
      Unit u0;
      for (int i = 0; S.next(i, u0); ++i) {
        OneUnit S1; S1.u = u0; S1.valid = true;
        EpiRes E; E.src = xo_lat; E.dst = xo_lat; E.gate = p.mod + ((size_t)layer * 5 + (u0.pm >> 4)) * 6144 + 5 * 1024;
        gemm_phase(lds, Gemm{p.ACT, p.wt_down + (size_t)layer * DM * LDF, FFN}, S1, E);
      }
      if (hasc) norm_static(p, cl, 0, TLAT, TTOT);
    } break;
  }
}

#define XB_XCNT(j)  (256  + 64 * (j))
#define XB_XSUB(j)  (1280 + 64 * (j))
#define XB_XGEN(j)  (2304 + 64 * (j))
#define XB_TOP      3328
#define XB_TOPGEN   3392
#define XCD_BAR_WORDS 3456
#define LAS __attribute__((address_space(3)))
DI unsigned xb_ld(unsigned* p) { return __hip_atomic_load(p, __ATOMIC_RELAXED, __HIP_MEMORY_SCOPE_AGENT); }
DI unsigned xb_add(unsigned* p, unsigned v) { return __hip_atomic_fetch_add(p, v, __ATOMIC_RELAXED, __HIP_MEMORY_SCOPE_AGENT); }
DI unsigned xb_xcc_id() { return (unsigned)__builtin_amdgcn_s_getreg((3 << 11) | 20) & 0xFu; }
struct XcdBarrier { unsigned* bar; unsigned x; volatile LAS unsigned* st; };
DI XcdBarrier xcd_barrier_post(unsigned* bar, volatile LAS unsigned* st) {
  XcdBarrier b; b.bar = bar; b.x = xb_xcc_id(); b.st = st;
  if (threadIdx.x == 0) (void)xb_add(&bar[XB_XCNT(b.x)], 1u);
  return b;
}
DI void xcd_barrier_complete(unsigned* bar, unsigned x, unsigned& nloc, unsigned& nx) {
  const unsigned G = gridDim.x;
  unsigned sum, cnt, mine;
  for (;;) {
    sum = 0u; cnt = 0u; mine = 0u;
#pragma unroll
    for (unsigned j = 0; j < 16; ++j) { const unsigned c = xb_ld(&bar[XB_XCNT(j)]); sum += c; cnt += (c > 0u) ? 1u : 0u; mine = (j == x) ? c : mine; }
    if (sum == G) break;
    __builtin_amdgcn_s_sleep(1);
  }
  nloc = mine > 0u ? mine : 1u; nx = cnt > 0u ? cnt : 1u;
}
DI void xcd_barrier(const XcdBarrier& b) {
  asm volatile("s_waitcnt vmcnt(0)" ::: "memory");
  __syncthreads();
  if (threadIdx.x == 0) {
    unsigned* bar = b.bar;
    unsigned bx = b.x;
    asm volatile("" : "+s"(bx));
    __builtin_amdgcn_s_waitcnt(0);
    unsigned nloc = b.st[0], nx = b.st[1];
    if (nloc == 0u) { xcd_barrier_complete(bar, bx, nloc, nx); b.st[0] = nloc; b.st[1] = nx; }
    const unsigned old = xb_add(&bar[XB_XSUB(bx)], 1u);
    const unsigned gen = old / nloc;
    if (old + 1u == (gen + 1u) * nloc) {
      __builtin_amdgcn_fence(__ATOMIC_RELEASE, "agent");
      asm volatile("s_waitcnt vmcnt(0)" ::: "memory");
      const unsigned og = xb_add(&bar[XB_TOP], 1u);
      const unsigned tg = og / nx;
      if (og + 1u == (tg + 1u) * nx) xb_add(&bar[XB_TOPGEN], 1u);
      else { while (xb_ld(&bar[XB_TOPGEN]) == tg) __builtin_amdgcn_s_sleep(1); }
      __builtin_amdgcn_fence(__ATOMIC_ACQUIRE, "agent");
      xb_add(&bar[XB_XGEN(bx)], 1u);
      asm volatile("s_waitcnt vmcnt(0)" ::: "memory");
    } else {
      while (xb_ld(&bar[XB_XGEN(bx)]) == gen) __builtin_amdgcn_s_sleep(1);
      __builtin_amdgcn_fence(__ATOMIC_ACQUIRE, "agent");
      asm volatile("s_waitcnt vmcnt(0)" ::: "memory");
    }
  }
  __syncthreads();
}


__global__ void __launch_bounds__(512, 2) fwd_megakernel(Params p) {
  extern __shared__ __attribute__((aligned(16))) unsigned char dsm[];
  char* smem = (char*)dsm;
  cg::grid_group grid = cg::this_grid();
  if (threadIdx.x == 0) *(uint4*)(dsm + 131072) = make_uint4(0u, 0u, 0u, 0u);
  __syncthreads();
  XcdBarrier xb = xcd_barrier_post(p.counters + 1024, (volatile LAS unsigned*)(dsm + 131072));
  phase0(p, smem);
  grid.sync();
  norm_static(p, 0, 0, TLAT, TTOT);
  xcd_barrier(xb);
  for (int g = 1; g <= 7 * NLAYER; ++g) {
    run_gphase(p, g, smem);
#ifdef PROBE_DOUBLE
    if ((g - 1) % 7 + 1 == PROBE_DOUBLE) { xcd_barrier(xb); run_gphase(p, g, smem, 100); }
#endif
    if (g < 7 * NLAYER) xcd_barrier(xb);
  }
}

extern "C" void kernel_launch(void* const* d_in, const int* in_sizes, int n_in, void* d_out, int out_size, void* d_ws,
                              size_t ws_size, hipStream_t stream) {
  Params p{};
  p.x = (const float*)d_in[0]; p.c = (const float*)d_in[1]; p.ctx = (const float*)d_in[2]; p.c_ctx = (const float*)d_in[3];
  p.w_mod = (const float*)d_in[4]; p.b_mod = (const float*)d_in[5]; p.norm_attn = (const float*)d_in[6];
  p.norm_ffn = (const float*)d_in[7]; p.w_in = (const float*)d_in[8]; p.qk_norm = (const float*)d_in[9];
  p.sink = (const float*)d_in[10]; p.rpb = (const float*)d_in[11]; p.w_out = (const float*)d_in[12];
  p.w_gate = (const float*)d_in[13]; p.w_up = (const float*)d_in[14]; p.w_down = (const float*)d_in[15];
  p.out = (float*)d_out;
  char* w = (char*)d_ws;
  size_t off = 0;
  auto take = [&](size_t bytes) { char* r = w + off; off += (bytes + 255) & ~(size_t)255; return r; };
  p.counters = (unsigned*)take(4096 + XCD_BAR_WORDS * 4);
  p.wt_in = (u16*)take((size_t)NLAYER * INW * LDK * 2);
  p.wt_out = (u16*)take((size_t)NLAYER * DM * LDK * 2);
  p.wt_gu = (u16*)take((size_t)NLAYER * GUW * LDK * 2);
  p.wt_down = (u16*)take((size_t)NLAYER * DM * LDF * 2);
  p.H = (u16*)take((size_t)TTOT * LDK * 2);
  p.mod = (float*)take((size_t)NLAYER * 5 * 6144 * 4);
  p.xctx = (float*)take((size_t)TCTX * DM * 4);
  p.rope = (float*)take((size_t)SEQL * 32 * 2 * 4);
  p.bounds = (float*)take(256);
  p.QKV = (u16*)take((size_t)NBATCH * 32 * LTOT * 64 * 2);
  p.O = (u16*)take((size_t)TTOT * LDK * 2);
  p.ACT = p.QKV;

  hipMemsetAsync(p.counters, 0, 4096 + XCD_BAR_WORDS * 4, stream);

  static int grid_blocks = 0;
  if (!grid_blocks) {
    int dev = 0, cus = 0, per_cu = 0;
    hipGetDevice(&dev);
    hipDeviceGetAttribute(&cus, hipDeviceAttributeMultiprocessorCount, dev);
    hipFuncSetAttribute((const void*)fwd_megakernel, hipFuncAttributeMaxDynamicSharedMemorySize, DYN_LDS);
    hipOccupancyMaxActiveBlocksPerMultiprocessor(&per_cu, fwd_megakernel, NTHR, DYN_LDS);
    if (per_cu > 1) per_cu = 1;
    if (per_cu < 1) per_cu = 1;
    grid_blocks = cus * per_cu;
  }
  void* args[] = {&p};
  hipError_t e = hipLaunchCooperativeKernel((void*)fwd_megakernel, dim3(grid_blocks), dim3(NTHR), args, DYN_LDS, stream);
  if (e != hipSuccess) fprintf(stderr, "cooperative launch failed: %s (grid %d)\n", hipGetErrorString(e), grid_blocks);
}
```

```cpp
#include <hip/hip_runtime.h>
#include <hip/hip_cooperative_groups.h>
#include <cstdio>
namespace cg = cooperative_groups;

typedef unsigned short u16;
typedef __attribute__((ext_vector_type(8))) short bf16x8;
typedef __attribute__((ext_vector_type(16))) float f32x16;
typedef __attribute__((ext_vector_type(4))) float f32x4;
typedef __attribute__((ext_vector_type(2))) float f32x2;
typedef __attribute__((ext_vector_type(2))) __bf16 bf16x2_t;
#define DI __device__ __forceinline__
#define LAS __attribute__((address_space(3)))
#define MFMA32(a, b, c) __builtin_amdgcn_mfma_f32_32x32x16_bf16((a), (b), (c), 0, 0, 0)

constexpr int DM = 1024, NBATCH = 4, SEQL = 4096, CTXL = 256, LTOT = 4352;
constexpr int TLAT = NBATCH * SEQL, TCTX = NBATCH * CTXL, TTOT = TLAT + TCTX;
constexpr int NLAYER = 4, INW = 2048, FFN = 2816, GUW = 2 * FFN;
constexpr int LDK = DM, LDF = FFN;
constexpr int NTHR = 512;
constexpr int DYN_LDS = 131072 + 64;
constexpr float EPSV = 1e-6f;
constexpr float LOG2E = 1.4426950408889634f;

struct Params {
  const float *x, *c, *ctx, *c_ctx, *w_mod, *b_mod, *norm_attn, *norm_ffn, *w_in, *qk_norm, *sink, *rpb,
              *w_out, *w_gate, *w_up, *w_down;
  float* out;
  u16 *wt_in, *wt_out, *wt_gu, *wt_down, *H, *QKV, *O, *ACT;
  float *mod, *xctx, *rope, *bounds;
  unsigned* counters;
};

DI unsigned pack_bf16(float a, float b) {
  f32x2 v = {a, b};
  bf16x2_t r = __builtin_convertvector(v, bf16x2_t);
  return __builtin_bit_cast(unsigned, r);
}
DI u16 f2bf(float a) { return (u16)(pack_bf16(a, 0.f) & 0xffffu); }
DI int tidx() { int t = threadIdx.x; asm volatile("" : "+v"(t)); return t; }
DI int crow(int r, int h) { return (r & 3) + 8 * (r >> 2) + 4 * h; }

DI int grab(unsigned* ctr) {
  __shared__ int s_grab;
  if (threadIdx.x == 0) s_grab = (int)atomicAdd(ctr, 1u);
  __syncthreads();
  int v = s_grab;
  __syncthreads();
  return v;
}

DI void phase0(const Params& p, char* smem) {
  const int tid = tidx();
  constexpr int NWP = NLAYER * 2880 / 2, NMOD = NLAYER * 96, NROPE = 256, NBND = 1;
  const float* w_in_ = p.w_in; const float* w_out_ = p.w_out; const float* w_gate_ = p.w_gate;
  const float* w_up_ = p.w_up; const float* w_down_ = p.w_down;
  asm volatile("" : "+v"(w_in_), "+v"(w_out_), "+v"(w_gate_), "+v"(w_up_), "+v"(w_down_));
  {
    const int half = tid >> 8, t = tid & 255;
    float* tile = (float*)(smem + half * 16640);
    const float* src; int N, k0, n0, Kd, up, kind; u16* dst;
    const float* nsrc = nullptr; int nN = 0, nk0 = 0, nn0 = 0, nKd = 0, nup = 0, nkind = 0; u16* ndst = nullptr;
    float4 cur[4], nxt[4];
#define WDECODE(item_, src_, N_, k0_, n0_, Kd_, up_, kind_, dst_)                                                              \
    {                                                                                                                          \
      const int it2_ = (item_) * 2 + half; const int layer_ = it2_ / 2880; int idx_ = it2_ % 2880; up_ = 0;                    \
      if (idx_ < 512) { kind_ = 0; k0_ = (idx_ >> 5) * 64; n0_ = (idx_ & 31) * 64; src_ = w_in_ + (size_t)layer_ * DM * INW; N_ = INW; dst_ = p.wt_in + (size_t)layer_ * INW * DM; Kd_ = DM; } \
      else if (idx_ < 768) { idx_ -= 512; kind_ = 0; k0_ = (idx_ >> 4) * 64; n0_ = (idx_ & 15) * 64; src_ = w_out_ + (size_t)layer_ * DM * DM; N_ = DM; dst_ = p.wt_out + (size_t)layer_ * DM * DM; Kd_ = DM; } \
      else if (idx_ < 2176) { idx_ -= 768; up_ = idx_ >= 704; if (up_) idx_ -= 704; kind_ = 1; k0_ = (idx_ / 44) * 64; n0_ = (idx_ % 44) * 64; \
        src_ = (up_ ? w_up_ : w_gate_) + (size_t)layer_ * DM * FFN; N_ = FFN; dst_ = p.wt_gu + (size_t)layer_ * GUW * DM; Kd_ = DM; } \
      else { idx_ -= 2176; kind_ = 0; k0_ = (idx_ >> 4) * 64; n0_ = (idx_ & 15) * 64; src_ = w_down_ + (size_t)layer_ * FFN * DM; N_ = DM; dst_ = p.wt_down + (size_t)layer_ * DM * FFN; Kd_ = FFN; } \
    }
#define WLOAD(v_, src_, N_, k0_, n0_)                                                                                          \
    _Pragma("unroll") for (int ps = 0; ps < 4; ++ps) {                                                                         \
      int kk = (t >> 4) + 16 * ps, nn = (t & 15) * 4;                                                                          \
      v_[ps] = *(const float4*)(src_ + (size_t)(k0_ + kk) * N_ + n0_ + nn);                                                    \
    }
    int item = blockIdx.x;
    if (item < NWP) { WDECODE(item, src, N, k0, n0, Kd, up, kind, dst); WLOAD(cur, src, N, k0, n0); }
    for (; item < NWP; item += gridDim.x) {
      const int nitem = item + gridDim.x;
      if (nitem < NWP) { WDECODE(nitem, nsrc, nN, nk0, nn0, nKd, nup, nkind, ndst); WLOAD(nxt, nsrc, nN, nk0, nn0); }
#pragma unroll
      for (int ps = 0; ps < 4; ++ps) {
        int kk = (t >> 4) + 16 * ps, nn = (t & 15) * 4;
        tile[kk * 65 + nn] = cur[ps].x; tile[kk * 65 + nn + 1] = cur[ps].y; tile[kk * 65 + nn + 2] = cur[ps].z; tile[kk * 65 + nn + 3] = cur[ps].w;
      }
      __syncthreads();
      {
        int n = t >> 2, kc = (t & 3) * 16;
        unsigned w[8];
#pragma unroll
        for (int j = 0; j < 8; ++j) w[j] = pack_bf16(tile[(kc + 2 * j) * 65 + n], tile[(kc + 2 * j + 1) * 65 + n]);
        int col = n0 + n;
        int row = kind ? ((col >> 7) * 256 + up * 128 + (col & 127)) : col;
        uint4* d = (uint4*)(dst + (size_t)row * Kd + k0 + kc);
        d[0] = make_uint4(w[0], w[1], w[2], w[3]);
        d[1] = make_uint4(w[4], w[5], w[6], w[7]);
      }
      __syncthreads();
#pragma unroll
      for (int ps = 0; ps < 4; ++ps) cur[ps] = nxt[ps];
      src = nsrc; N = nN; k0 = nk0; n0 = nn0; Kd = nKd; up = nup; kind = nkind; dst = ndst;
    }
#undef WDECODE
#undef WLOAD
  }
  for (int item = NWP + blockIdx.x; item < NWP + NMOD + NROPE + NBND; item += gridDim.x) {
    if (false) {
    } else if (item < NWP + NMOD) {
      int it = item - NWP, layer = it / 96, cg0 = (it % 96) * 64;
      float* sc = (float*)smem;
      float* red = sc + 5 * 1024;
      for (int e = tid; e < 5 * 1024; e += NTHR) {
        int mb = e >> 10, k = e & 1023;
        float v = (mb < 4) ? p.c[mb * 1024 + k] : p.c_ctx[k];
        sc[e] = v / (1.f + __expf(-v));
      }
      __syncthreads();
      int col = cg0 + (tid & 63), kq = tid >> 6;
      const float* w = p.w_mod + (size_t)layer * DM * 6144 + col;
      float a0 = 0, a1 = 0, a2 = 0, a3 = 0, a4 = 0;
#pragma unroll 8
      for (int k = kq * 128; k < kq * 128 + 128; ++k) {
        float wv = w[(size_t)k * 6144];
        a0 += sc[k] * wv; a1 += sc[1024 + k] * wv; a2 += sc[2048 + k] * wv; a3 += sc[3072 + k] * wv; a4 += sc[4096 + k] * wv;
      }
      int c64 = tid & 63;
      red[(kq * 5 + 0) * 64 + c64] = a0; red[(kq * 5 + 1) * 64 + c64] = a1; red[(kq * 5 + 2) * 64 + c64] = a2;
      red[(kq * 5 + 3) * 64 + c64] = a3; red[(kq * 5 + 4) * 64 + c64] = a4;
      __syncthreads();
      for (int e = tid; e < 5 * 64; e += NTHR) {
        int mb = e >> 6, cc = e & 63;
        float s = 0.f;
#pragma unroll
        for (int q = 0; q < 8; ++q) s += red[(q * 5 + mb) * 64 + cc];
        p.mod[((size_t)layer * 5 + mb) * 6144 + cg0 + cc] = s + p.b_mod[layer * 6144 + cg0 + cc];
      }
      __syncthreads();
    } else if (item >= NWP + NMOD + NROPE) {
      unsigned* mx = (unsigned*)smem;
      for (int e = tid; e < NLAYER * 10; e += NTHR) mx[e] = 0u;
      __syncthreads();
      for (int e = tid; e < NLAYER * 6 * 64; e += NTHR) atomicMax(&mx[(e / 384) * 10 + (e % 384) / 64], __float_as_uint(fabsf(p.qk_norm[e])));
      for (int e = tid; e < NLAYER * 4 * 465; e += NTHR) atomicMax(&mx[(e / 1860) * 10 + 6 + (e % 1860) / 465], __float_as_uint(fabsf(p.rpb[e])));
      __syncthreads();
      if (tid < NLAYER * 8) {
        int l = tid >> 3, j = tid & 7; float v = 0.f;
        if (j < 3) v = 0.125f * LOG2E * 64.f * 1.02f * __uint_as_float(mx[l * 10 + 2 * j]) * __uint_as_float(mx[l * 10 + 2 * j + 1]);
        else if (j >= 4) v = LOG2E * __uint_as_float(mx[l * 10 + 6 + (j - 4)]);
        p.bounds[tid] = v;
      }
      __syncthreads();
    } else {
      int e = (item - NWP - NMOD) * NTHR + tid;
      int t = e >> 5, pi = e & 31;
      float pos = (pi < 16) ? (float)(t >> 6) : (float)(t & 63);
      float inv = exp2f(-(float)(pi & 15) * (13.287712379549449f / 16.0f));
      float ang = pos * inv;
      p.rope[2 * e] = __cosf(ang);
      p.rope[2 * e + 1] = __sinf(ang);
    }
  }
}

DI const float* xrow_src(const Params& p, int layer, int t) {
  const float* a = p.x; const float* b = p.out; const float* c = p.ctx; const float* d = p.xctx;
  asm volatile("" : "+v"(a), "+v"(b), "+v"(c), "+v"(d));
  if (t < TLAT) return (layer == 0 ? a : b) + (size_t)t * DM;
  return (layer == 0 ? c : d) + (size_t)(t - TLAT) * DM;
}
DI float* xrow_dst(const Params& p, int t) {
  float* b = p.out; float* d = p.xctx;
  asm volatile("" : "+v"(b), "+v"(d));
  if (t < TLAT) return b + (size_t)t * DM;
  return d + (size_t)(t - TLAT) * DM;
}
DI int mb_of(int t) { return t < TLAT ? (t >> 12) : 4; }

DI void norm_row(const Params& p, int layer, int which, int t, int lane) {
  const float* g = (which ? p.norm_ffn : p.norm_attn) + layer * DM;
  const float* xr = which ? (const float*)xrow_dst(p, t) : xrow_src(p, layer, t);
  const float* md = p.mod + ((size_t)layer * 5 + mb_of(t)) * 6144 + (which ? 3 * 1024 : 0);
  float4 v[4];
  float ss = 0.f;
#pragma unroll
  for (int j = 0; j < 4; ++j) {
    v[j] = *(const float4*)(xr + lane * 4 + 256 * j);
    ss += v[j].x * v[j].x + v[j].y * v[j].y + v[j].z * v[j].z + v[j].w * v[j].w;
  }
#pragma unroll
  for (int o = 32; o >= 1; o >>= 1) ss += __shfl_xor(ss, o);
  float r = rsqrtf(ss * (1.f / 1024.f) + EPSV);
#pragma unroll
  for (int j = 0; j < 4; ++j) {
    int col = lane * 4 + 256 * j;
    float4 gg = *(const float4*)(g + col);
    float4 sh = *(const float4*)(md + col);
    float4 sc = *(const float4*)(md + 1024 + col);
    float o0 = v[j].x * r * gg.x * (1.f + sc.x) + sh.x;
    float o1 = v[j].y * r * gg.y * (1.f + sc.y) + sh.y;
    float o2 = v[j].z * r * gg.z * (1.f + sc.z) + sh.z;
    float o3 = v[j].w * r * gg.w * (1.f + sc.w) + sh.w;
    *(uint2*)(p.H + (size_t)t * LDK + col) = make_uint2(pack_bf16(o0, o1), pack_bf16(o2, o3));
  }
}
template <int R>
DI void norm_rows(const Params& p, int layer, int which, int t0, int tstep, int lane) {
  const float* g = (which ? p.norm_ffn : p.norm_attn) + layer * DM;
  const float* md = p.mod + ((size_t)layer * 5 + mb_of(t0)) * 6144 + (which ? 3 * 1024 : 0);
  float4 v[R][4];
  float ss[R];
#pragma unroll
  for (int r = 0; r < R; ++r) {
    const float* xr = which ? (const float*)xrow_dst(p, t0 + r * tstep) : xrow_src(p, layer, t0 + r * tstep);
#pragma unroll
    for (int j = 0; j < 4; ++j) v[r][j] = *(const float4*)(xr + lane * 4 + 256 * j);
  }
#pragma unroll
  for (int r = 0; r < R; ++r) {
    ss[r] = 0.f;
#pragma unroll
    for (int j = 0; j < 4; ++j) ss[r] += v[r][j].x * v[r][j].x + v[r][j].y * v[r][j].y + v[r][j].z * v[r][j].z + v[r][j].w * v[r][j].w;
  }
#pragma unroll
  for (int o = 32; o >= 1; o >>= 1)
#pragma unroll
    for (int r = 0; r < R; ++r) ss[r] += __shfl_xor(ss[r], o);
#pragma unroll
  for (int r = 0; r < R; ++r) ss[r] = rsqrtf(ss[r] * (1.f / 1024.f) + EPSV);
#pragma unroll
  for (int j = 0; j < 4; ++j) {
    int col = lane * 4 + 256 * j;
    float4 gg = *(const float4*)(g + col);
    float4 sh = *(const float4*)(md + col);
    float4 sc = *(const float4*)(md + 1024 + col);
    float m0 = gg.x * (1.f + sc.x), m1 = gg.y * (1.f + sc.y), m2 = gg.z * (1.f + sc.z), m3 = gg.w * (1.f + sc.w);
#pragma unroll
    for (int r = 0; r < R; ++r)
      *(uint2*)(p.H + (size_t)(t0 + r * tstep) * LDK + col) =
          make_uint2(pack_bf16(v[r][j].x * ss[r] * m0 + sh.x, v[r][j].y * ss[r] * m1 + sh.y), pack_bf16(v[r][j].z * ss[r] * m2 + sh.z, v[r][j].w * ss[r] * m3 + sh.w));
  }
}
DI void norm_static(const Params& p, int layer, int which, int row0, int row1) {
  const int tid = tidx(), lane = tid & 63, wid = tid >> 6;
  for (int t = row0 + blockIdx.x * 8 + wid; t < row1; t += gridDim.x * 8) norm_row(p, layer, which, t, lane);
}
DI void norm_dyn(const Params& p, int layer, int which, int row0, int row1, unsigned* ctr) {
  const int tid = tidx(), lane = tid & 63, wid = tid >> 6;
  const int nchunk = (row1 - row0) >> 5;
  while (true) {
    int ch = grab(ctr);
    if (ch >= nchunk) break;
    norm_rows<4>(p, layer, which, row0 + ch * 32 + wid, 8, lane);
  }
}

namespace pg8 {
typedef unsigned short bf16_t;
constexpr int BM = 256, BK = 64, HALF = 128, HTB = HALF * BK * 2, STAGE_BYTES = 8 * HTB, NXCD = 8, WGM = 8;
DI int lds_byte(int r, int c) { const int st = (r >> 4) * 2 + (c >> 5), rr = r & 15, cc = c & 31, ob = rr * 64 + cc * 2; return st * 1024 + (ob ^ (((ob >> 9) & 1) << 5)); }
DI void stage_rc(int b, int& R, int& C) { const int st = b / 1024, sb = b % 1024, swz = sb ^ (((sb >> 9) & 1) << 5); R = (st >> 1) * 16 + swz / 64; C = (st & 1) * 32 + (swz % 64) / 2; }
DI int perm32(int rho) { const int n = rho >> 4, i = rho & 15; return 8 * (i >> 2) + 4 * n + (i & 3); }
struct Unit { int pm, pn; };
struct Gemm { const bf16_t* A; const bf16_t* Bt; int K; };

struct TileOrder {
  int nM, nN, nwg, G, c, remap;
  DI void init(int nM_, int nN_, int G_, int c_, int remap_) { nM = nM_; nN = nN_; nwg = nM * nN; G = G_; c = c_; remap = remap_; }
  DI bool next(int i, Unit& u) const {
    long L = (long)i * G + c;
    if (remap) {
      if (c >= 240) { if (i >= 3) return false; }
      else if (c >= 128 && c < 144 && i == 5) L = 4L * G + (c + 112);
      else if (c >= 144 && c < 160 && i == 5) L = 3L * G + (c + 96);
    }
    if (L >= nwg) return false;
    int wgid = (int)L; { const int q = nwg / NXCD, r = nwg % NXCD, xcd = wgid % NXCD, off = wgid / NXCD; wgid = (xcd < r ? xcd * (q + 1) : r * (q + 1) + (xcd - r) * q) + off; }
    const int nig = WGM * nN, gid = wgid / nig, fm = gid * WGM, gsz = (nM - fm) < WGM ? (nM - fm) : WGM;
    u.pm = fm + ((wgid % nig) % gsz); u.pn = (wgid % nig) / gsz; return true;
  }
};
struct OneUnit {
  Unit u; bool valid;
  DI bool next(int i, Unit& o) const { if (i != 0 || !valid) return false; o = u; return true; }
};

template <class Epi, class Sched>
DI void gemm_phase(LAS unsigned char* lds, const Gemm g, const Sched& S, const Epi& E) {
  const int tid = tidx(), wid = __builtin_amdgcn_readfirstlane(tid >> 6), lane = tid & 63, wr = wid >> 2, wc = wid & 3, fr = lane & 15, fq = lane >> 4;
  int K = g.K; asm volatile("" : "+s"(K));
  const int nt = K / BK;
  unsigned voffA[2], voffB[2];
#pragma unroll
  for (int i = 0; i < 2; ++i) {
    int R, C; stage_rc(tid * 16 + i * 8192, R, C);
    int Rb = R;
    if (Epi::BMAP == 1) Rb = (R & ~31) + perm32(R & 31);
    if (Epi::BMAP == 2) Rb = 64 * (R >> 5) + perm32(R & 31);
    voffA[i] = (unsigned)(R * K + C) * 2u; voffB[i] = (unsigned)(Rb * K + C) * 2u;
  }
  const size_t kstep = (size_t)(BK * 2);
  const size_t hstep = (size_t)HALF * K * 2;
  const size_t hstepB = (Epi::BMAP == 2) ? (size_t)32 * K * 2 : hstep;
  const size_t tstep = 2 * hstep;
  const unsigned ldsw = (unsigned)wid * 1024u;
  const int aoff = lds_byte(wr * 64 + fr, fq * 8), boff = lds_byte(wc * 32 + fr, fq * 8);
#define PG8_SA(b, h) (((b) * 2 + (h)) * HTB)
#define PG8_SB(b, h) ((4 + (b) * 2 + (h)) * HTB)
#define PG8_STAGE(bufoff, gbase, voff) do { _Pragma("unroll") for (int _i = 0; _i < 2; ++_i) \
    __builtin_amdgcn_global_load_lds((const unsigned*)((const char*)(gbase) + (voff)[_i]), (LAS unsigned*)(lds + (bufoff) + ldsw + _i * 8192), 16, 0, 0); } while (0)
#define PG8_LDA(dst, b, h) do { _Pragma("unroll") for (int m = 0; m < 4; ++m) _Pragma("unroll") for (int k = 0; k < 2; ++k) dst[m][k] = *(const LAS bf16x8*)(lds + PG8_SA(b, h) + aoff + m * 2048 + k * 1024); } while (0)
#define PG8_LDB(dst, b, h) do { _Pragma("unroll") for (int n = 0; n < 2; ++n) _Pragma("unroll") for (int k = 0; k < 2; ++k) dst[n][k] = *(const LAS bf16x8*)(lds + PG8_SB(b, h) + boff + n * 2048 + k * 1024); } while (0)
#define PG8_MMA(ai, bj, At, Bt) do { __builtin_amdgcn_s_setprio(1); _Pragma("unroll") for (int m = 0; m < 4; ++m) _Pragma("unroll") for (int n = 0; n < 2; ++n) _Pragma("unroll") for (int k = 0; k < 2; ++k) \
    acc[ai][bj][m][n] = __builtin_amdgcn_mfma_f32_16x16x32_bf16(Bt[n][k], At[m][k], acc[ai][bj][m][n], 0, 0, 0); __builtin_amdgcn_s_setprio(0); } while (0)
#define PG8_WAIT_V(n) asm volatile("s_waitcnt vmcnt(" #n ")" ::: "memory")
#define PG8_WAIT_L(n) asm volatile("s_waitcnt lgkmcnt(" #n ")" ::: "memory")
#define PG8_BAR __builtin_amdgcn_s_barrier()
#define PG8_SCHED __builtin_amdgcn_sched_barrier(0)
  Unit cur, nxt; int ui = 0;
  if (!S.next(0, cur)) return;
  f32x4 acc[2][2][4][2];
#pragma unroll
  for (int a = 0; a < 2; ++a)
#pragma unroll
    for (int b = 0; b < 2; ++b)
#pragma unroll
      for (int m = 0; m < 4; ++m)
#pragma unroll
        for (int n = 0; n < 2; ++n) acc[a][b][m][n] = (f32x4){0.f, 0.f, 0.f, 0.f};
  bf16x8 At[4][2], B0[2][2], B1[2][2];
  const char* cA = (const char*)g.A + (size_t)cur.pm * tstep; const char* cB = (const char*)g.Bt + (size_t)cur.pn * tstep;
  PG8_STAGE(PG8_SB(0, 0), cB, voffB); PG8_STAGE(PG8_SA(0, 0), cA, voffA); PG8_STAGE(PG8_SB(0, 1), cB + hstepB, voffB); PG8_STAGE(PG8_SA(0, 1), cA + hstep, voffA);
  if (wr == 1) PG8_BAR;
  PG8_WAIT_V(4); PG8_BAR;
  PG8_STAGE(PG8_SB(1, 0), cB + kstep, voffB); PG8_STAGE(PG8_SA(1, 0), cA + kstep, voffA); PG8_STAGE(PG8_SB(1, 1), cB + hstepB + kstep, voffB);
  PG8_WAIT_V(6); PG8_BAR;
  for (;;) {
    const bool has_next = S.next(ui + 1, nxt);
    const char* nA = has_next ? (const char*)g.A + (size_t)nxt.pm * tstep : cA; const char* nB = has_next ? (const char*)g.Bt + (size_t)nxt.pn * tstep : cB;
    for (int t = 0; t < nt; t += 2) {
      const bool last = (t == nt - 2);
      const char* a1 = cA + (size_t)(t + 1) * kstep;
      const char* a2 = last ? nA : cA + (size_t)(t + 2) * kstep; const char* b2 = last ? nB : cB + (size_t)(t + 2) * kstep;
      const char* a3 = a2 + kstep; const char* b3 = b2 + kstep;
      PG8_LDB(B0, 0, 0); PG8_SCHED; PG8_LDA(At, 0, 0); PG8_STAGE(PG8_SA(1, 1), a1 + hstep, voffA);
      PG8_WAIT_L(8); PG8_BAR; PG8_WAIT_L(0); PG8_MMA(0, 0, At, B0); PG8_BAR; PG8_SCHED;
      PG8_LDB(B1, 0, 1); PG8_STAGE(PG8_SB(0, 0), b2, voffB);
      PG8_BAR; PG8_WAIT_L(0); PG8_MMA(0, 1, At, B1); PG8_BAR;
      PG8_LDA(At, 0, 1); PG8_STAGE(PG8_SA(0, 0), a2, voffA);
      PG8_BAR; PG8_WAIT_L(0); PG8_MMA(1, 0, At, B0); PG8_BAR; PG8_SCHED;
      PG8_STAGE(PG8_SB(0, 1), b2 + hstepB, voffB);
      PG8_WAIT_V(6); PG8_BAR; PG8_MMA(1, 1, At, B1); PG8_BAR;
      PG8_LDB(B0, 1, 0); PG8_SCHED; PG8_LDA(At, 1, 0); PG8_STAGE(PG8_SA(0, 1), a2 + hstep, voffA);
      PG8_WAIT_L(8); PG8_BAR; PG8_WAIT_L(0); PG8_MMA(0, 0, At, B0); PG8_BAR; PG8_SCHED;
      PG8_LDB(B1, 1, 1); PG8_STAGE(PG8_SB(1, 0), b3, voffB);
      PG8_BAR; PG8_WAIT_L(0); PG8_MMA(0, 1, At, B1); PG8_BAR;
      PG8_LDA(At, 1, 1); PG8_STAGE(PG8_SA(1, 0), a3, voffA);
      PG8_BAR; PG8_WAIT_L(0); PG8_MMA(1, 0, At, B0); PG8_BAR; PG8_SCHED;
      PG8_STAGE(PG8_SB(1, 1), b3 + hstepB, voffB);
      PG8_WAIT_V(6); PG8_BAR; PG8_MMA(1, 1, At, B1); PG8_BAR;
    }
    E(acc, cur, wr, wc, fr, fq);
    if (!has_next) break;
#pragma unroll
    for (int a = 0; a < 2; ++a)
#pragma unroll
      for (int b = 0; b < 2; ++b)
#pragma unroll
        for (int m = 0; m < 4; ++m)
#pragma unroll
          for (int n = 0; n < 2; ++n) acc[a][b][m][n] = (f32x4){0.f, 0.f, 0.f, 0.f};
    cur = nxt; cA = nA; cB = nB; ++ui;
  }
  PG8_WAIT_V(0);
  if (wr == 0) PG8_BAR;
  PG8_BAR;
#undef PG8_SA
#undef PG8_SB
#undef PG8_STAGE
#undef PG8_LDA
#undef PG8_LDB
#undef PG8_MMA
#undef PG8_WAIT_V
#undef PG8_WAIT_L
#undef PG8_BAR
#undef PG8_SCHED
}

struct EpiRes {
  static constexpr int BMAP = 0;
  const float* src; float* dst; const float* gate;
  DI void operator()(const f32x4 (&acc)[2][2][4][2], const Unit& u, int wr, int wc, int fr, int fq) const {
    asm volatile("" ::: "memory");
    const int row0 = u.pm * BM + wr * 64 + fr, col0 = u.pn * BM + wc * 32 + 4 * fq;
    f32x4 gv[2][2];
#pragma unroll
    for (int bj = 0; bj < 2; ++bj)
#pragma unroll
      for (int n = 0; n < 2; ++n) gv[bj][n] = *(const f32x4*)(gate + col0 + bj * HALF + n * 16);
#pragma unroll
    for (int ai = 0; ai < 2; ++ai)
#pragma unroll
      for (int m = 0; m < 4; ++m) {
        const size_t ro = (size_t)(row0 + ai * HALF + m * 16) * DM + col0;
#pragma unroll
        for (int bj = 0; bj < 2; ++bj)
#pragma unroll
          for (int n = 0; n < 2; ++n) {
            f32x4 s = *(const f32x4*)(src + ro + bj * HALF + n * 16);
            *(f32x4*)(dst + ro + bj * HALF + n * 16) = s + gv[bj][n] * acc[ai][bj][m][n];
          }
      }
  }
};
struct EpiGU {
  static constexpr int BMAP = 1;
  u16* act;
  DI void operator()(const f32x4 (&acc)[2][2][4][2], const Unit& u, int wr, int wc, int fr, int fq) const {
    asm volatile("" ::: "memory");
    const int row0 = u.pm * BM + wr * 64 + fr, col0 = u.pn * HALF + wc * 32 + 8 * fq;
#pragma unroll
    for (int ai = 0; ai < 2; ++ai)
#pragma unroll
      for (int m = 0; m < 4; ++m) {
        float a[8];
#pragma unroll
        for (int n = 0; n < 2; ++n)
#pragma unroll
          for (int e = 0; e < 4; ++e) {
            float gte = acc[ai][0][m][n][e], up = acc[ai][1][m][n][e];
            a[n * 4 + e] = gte * __builtin_amdgcn_rcpf(1.f + __builtin_amdgcn_exp2f(-gte * LOG2E)) * up;
          }
        *(uint4*)(act + (size_t)(row0 + ai * HALF + m * 16) * FFN + col0) =
            make_uint4(pack_bf16(a[0], a[1]), pack_bf16(a[2], a[3]), pack_bf16(a[4], a[5]), pack_bf16(a[6], a[7]));
      }
  }
};
struct EpiQKV {
  static constexpr int BMAP = 2;
  u16* qkv; const float* qkn; const float* rope; int rowbase;
  DI void operator()(const f32x4 (&acc)[2][2][4][2], const Unit& u, int wr, int wc, int fr, int fq) const {
    asm volatile("" ::: "memory");
    const int chunk = u.pn * 4 + wc;
    const bool isV = (chunk == 8 || chunk == 9 || (chunk >= 18 && chunk <= 21) || chunk >= 30);
    int gi = 0;
    if (chunk < 6) gi = 0; else if (chunk < 8) gi = 1; else if (chunk < 14) gi = 2; else if (chunk < 18) gi = 3;
    else if (chunk < 28) gi = 4; else gi = 5;
    const bool ropeT = (gi == 0 || gi == 1 || gi == 4 || gi == 5) && rowbase == 0;
    const float* gam = qkn + gi * 64;
    const float qs = (gi == 0 || gi == 2 || gi == 4) ? 0.125f * LOG2E : 1.f;
    f32x4 g4[2][2];
#pragma unroll
    for (int bj = 0; bj < 2; ++bj)
#pragma unroll
      for (int n = 0; n < 2; ++n) g4[bj][n] = *(const f32x4*)(gam + 32 * bj + 8 * fq + 4 * n);
#pragma unroll
    for (int ai = 0; ai < 2; ++ai)
#pragma unroll
      for (int m = 0; m < 4; ++m) {
        const int t = u.pm * BM + ai * HALF + wr * 64 + m * 16 + fr;
        int b, pos;
        if (rowbase == 0) { b = t >> 12; pos = t & 4095; } else { b = t >> 8; pos = 4096 + (t & 255); }
        u16* base = qkv + (size_t)(b * 32 + chunk) * LTOT * 64;
        if (isV) {
#pragma unroll
          for (int bj = 0; bj < 2; ++bj)
#pragma unroll
            for (int n = 0; n < 2; ++n)
#pragma unroll
              for (int e = 0; e < 4; ++e) {
                int d = 32 * bj + 8 * fq + 4 * n + e;
                base[(size_t)d * LTOT + pos] = f2bf(acc[ai][bj][m][n][e]);
              }
        } else {
          float ss = 0.f;
#pragma unroll
          for (int bj = 0; bj < 2; ++bj)
#pragma unroll
            for (int n = 0; n < 2; ++n)
#pragma unroll
              for (int e = 0; e < 4; ++e) ss += acc[ai][bj][m][n][e] * acc[ai][bj][m][n][e];
          ss += __shfl_xor(ss, 16);
          ss += __shfl_xor(ss, 32);
          const float rinv = rsqrtf(ss * (1.f / 64.f) + EPSV);
          float o1[8], o2[8];
#pragma unroll
          for (int n = 0; n < 2; ++n) {
            f32x4 cs0 = (f32x4){1.f, 0.f, 1.f, 0.f}, cs1 = cs0;
            if (ropeT) { const float* rp = rope + (size_t)pos * 64 + 2 * (8 * fq + 4 * n); cs0 = *(const f32x4*)rp; cs1 = *(const f32x4*)(rp + 4); }
#pragma unroll
            for (int e = 0; e < 4; ++e) {
              float x1 = acc[ai][0][m][n][e] * (rinv * qs) * g4[0][n][e];
              float x2 = acc[ai][1][m][n][e] * (rinv * qs) * g4[1][n][e];
              float c = (e < 2) ? cs0[2 * e] : cs1[2 * (e - 2)], s = (e < 2) ? cs0[2 * e + 1] : cs1[2 * (e - 2) + 1];
              o1[n * 4 + e] = x1 * c - x2 * s;
              o2[n * 4 + e] = x2 * c + x1 * s;
            }
          }
          u16* dst = base + (size_t)pos * 64 + 8 * fq;
          *(uint4*)(dst) = make_uint4(pack_bf16(o1[0], o1[1]), pack_bf16(o1[2], o1[3]), pack_bf16(o1[4], o1[5]), pack_bf16(o1[6], o1[7]));
          *(uint4*)(dst + 32) = make_uint4(pack_bf16(o2[0], o2[1]), pack_bf16(o2[2], o2[3]), pack_bf16(o2[4], o2[5]), pack_bf16(o2[6], o2[7]));
        }
      }
  }
};
}

constexpr int KROW = 144, VROW = 144;
constexpr int KT_B = 64 * KROW, VT_B = 64 * VROW, KV_B = KT_B + VT_B;
constexpr int RPB_OFF = 2 * KV_B;
constexpr int NAT_C = 384, NAT_B = 256, NAT_A = 384, NAT_LAT = NAT_C + NAT_B + NAT_A, NAT_CTX = 64;

DI void attn_item(const Params& p, int layer, int item, char* smem) {
  const int tid = tidx(), lane = tid & 63, wid = tid >> 6, l32 = lane & 31, h = lane >> 5;
  int mode, b, hh, qb;
  if (item < NAT_C) { mode = 0; b = item / 96; int rem = item % 96; hh = rem >> 4; qb = rem & 15; }
  else if (item < NAT_C + NAT_B) { int it = item - NAT_C; mode = 1; b = it >> 6; hh = (it & 63) >> 4; qb = it & 15; }
  else if (item < NAT_LAT) { int it = item - NAT_C - NAT_B; mode = 2; b = it / 96; int rem = it % 96; hh = rem >> 4; qb = rem & 15; }
  else { int it = item - NAT_LAT; mode = 3; b = it >> 4; hh = it & 15; qb = 0; }

  int qchunk, kchunk, vchunk, head16, t0 = 0, t1 = 0, qpos0 = qb * 256;
  bool hasSink = false; float sinkv = 0.f;
  int maskmode = 0;
  if (mode == 0) { qchunk = 22 + hh; kchunk = 28 + hh / 3; vchunk = 30 + hh / 3; head16 = 10 + hh; t0 = 0; t1 = 64; }
  else if (mode == 1) {
    qchunk = 10 + hh; kchunk = 14 + hh; vchunk = 18 + hh; head16 = 6 + hh; maskmode = 1;
    t0 = min(max(4 * qb - 4, 0), 56); t1 = min(max(4 * qb + 3 - 4, 0), 56) + 8;
  } else if (mode == 2) {
    qchunk = hh; kchunk = 6 + hh / 3; vchunk = 8 + hh / 3; head16 = hh; maskmode = 2;
    t0 = max(0, 4 * qb - 2); t1 = min(64, 4 * qb + 6); hasSink = true; sinkv = p.sink[layer * 6 + hh];
  } else {
    head16 = hh; qpos0 = 4096;
    if (hh < 6) { qchunk = hh; kchunk = 6 + hh / 3; vchunk = 8 + hh / 3; hasSink = true; sinkv = p.sink[layer * 6 + hh]; }
    else if (hh < 10) { int hb = hh - 6; qchunk = 10 + hb; kchunk = 14 + hb; vchunk = 18 + hb; }
    else { int hc = hh - 10; qchunk = 22 + hc; kchunk = 28 + hc / 3; vchunk = 30 + hc / 3; }
  }
  const int n_it = 4 + (t1 - t0);
  const u16* Qb = p.QKV + (size_t)(b * 32 + qchunk) * LTOT * 64;
  const u16* Kb = p.QKV + (size_t)(b * 32 + kchunk) * LTOT * 64;
  const u16* Vb = p.QKV + (size_t)(b * 32 + vchunk) * LTOT * 64;
  float* s_rpb = (float*)(smem + RPB_OFF);
  if (mode == 1) {
    const float* rp = p.rpb + (size_t)(layer * 4 + hh) * 465;
    for (int e = tid; e < 465; e += NTHR) s_rpb[e] = rp[e] * LOG2E;
  }

  const int qpos = qpos0 + wid * 32 + l32;
  bf16x8 qf[4];
#pragma unroll
  for (int s = 0; s < 4; ++s) qf[s] = *(const bf16x8*)(Qb + (size_t)qpos * 64 + s * 16 + h * 8);

  f32x16 o0, o1;
#pragma unroll
  for (int r = 0; r < 16; ++r) { o0[r] = 0.f; o1[r] = 0.f; }
  const int btype = (mode == 3) ? (hh < 6 ? 0 : (hh < 10 ? 1 : 2)) : (mode == 0 ? 2 : (mode == 1 ? 1 : 0));
  float m_fix = p.bounds[layer * 8 + btype];
  if (mode == 1) m_fix += p.bounds[layer * 8 + 4 + hh];
  f32x16 cinit, lacc;
#pragma unroll
  for (int r = 0; r < 16; ++r) { cinit[r] = -m_fix; lacc[r] = 0.f; }
  const bf16x8 ones = {(short)0x3F80, (short)0x3F80, (short)0x3F80, (short)0x3F80, (short)0x3F80, (short)0x3F80, (short)0x3F80, (short)0x3F80};

  const int lr = tid >> 3, lc = tid & 7;
  uint4 ka0, va0, kb0, vb0;
#define TILE_OF(it) ((it) < 4 ? 64 + (it) : t0 + (it) - 4)
#define AGLOAD(K0, V0, tile)                                                           \
  {                                                                                    \
    K0 = *(const uint4*)(Kb + (size_t)((tile) * 64 + lr) * 64 + lc * 8);               \
    V0 = *(const uint4*)(Vb + (size_t)(lr) * LTOT + (tile) * 64 + lc * 8);             \
  }
#define ASWRITE(K0, V0, buf)                                                           \
  {                                                                                    \
    *(uint4*)(smem + (buf) * KV_B + (lr) * KROW + lc * 16) = K0;                       \
      \
                       \
    char* vd = smem + (buf) * KV_B + KT_B + (lr) * VROW + (16 * (lc >> 1) + 4 * (lc & 1)) * 2; \
    *(uint2*)(vd) = make_uint2(V0.x, V0.y);                                            \
    *(uint2*)(vd + 16) = make_uint2(V0.z, V0.w);                                       \
  }

  const int tq = qb * 256 + wid * 32 + l32;
  auto compute = [&](const int bufsel, const int tile) {
    bool skip = false;
    if (tile < 64) {
      if (maskmode == 1) {
        int qr = (qb * 256 + wid * 32) >> 6;
        int krw = min(max(qr - 4, 0), 56);
        skip = (tile < krw) || (tile >= krw + 8);
      } else if (maskmode == 2) {
        int q0w = qb * 256 + wid * 32, tk0 = tile * 64;
        skip = (tk0 > q0w + 31 + 128) || (tk0 + 63 < q0w - 128);
      }
    }
    if (!skip) {
      const char* sK = smem + bufsel * KV_B;
      const char* sV = sK + KT_B;
      f32x16 S[2];
      __builtin_amdgcn_s_setprio(1);
#pragma unroll
      for (int kt = 0; kt < 2; ++kt) {
#pragma unroll
        for (int s = 0; s < 4; ++s) {
          bf16x8 kf = *(const bf16x8*)(sK + (kt * 32 + l32) * KROW + s * 32 + h * 16);
          S[kt] = MFMA32(kf, qf[s], s == 0 ? cinit : S[kt]);
        }
      }
      __builtin_amdgcn_s_setprio(0);
      if (tile < 64 && maskmode == 1) {
        int qr = tq >> 6, qc = tq & 63;
        int ws = min(max(qc - 8, 0), 48);
        int dr = tile - qr + 7;
#pragma unroll
        for (int kt = 0; kt < 2; ++kt)
#pragma unroll
          for (int r = 0; r < 16; ++r) {
            int kc = kt * 32 + crow(r, h);
            bool ok = (unsigned)(kc - ws) < 16u;
            int bi = ok ? (dr * 31 + kc - qc + 15) : 0;
            float bv = s_rpb[bi];
            S[kt][r] = ok ? (S[kt][r] + bv) : -INFINITY;
          }
      } else if (tile < 64 && maskmode == 2) {
#pragma unroll
        for (int kt = 0; kt < 2; ++kt)
#pragma unroll
          for (int r = 0; r < 16; ++r) {
            int tk = tile * 64 + kt * 32 + crow(r, h);
            int dd = tq - tk;
            bool ok = (dd <= 128) && (dd >= -128);
            S[kt][r] = ok ? S[kt][r] : -INFINITY;
          }
      }
#pragma unroll
      for (int r = 0; r < 16; ++r) {
        S[0][r] = __builtin_amdgcn_exp2f(S[0][r]);
        S[1][r] = __builtin_amdgcn_exp2f(S[1][r]);
      }
#pragma unroll
      for (int kt = 0; kt < 2; ++kt)
#pragma unroll
        for (int s2 = 0; s2 < 2; ++s2) {
          uint4 pw;
          pw.x = pack_bf16(S[kt][8 * s2 + 0], S[kt][8 * s2 + 1]);
          pw.y = pack_bf16(S[kt][8 * s2 + 2], S[kt][8 * s2 + 3]);
          pw.z = pack_bf16(S[kt][8 * s2 + 4], S[kt][8 * s2 + 5]);
          pw.w = pack_bf16(S[kt][8 * s2 + 6], S[kt][8 * s2 + 7]);
          bf16x8 pf = __builtin_bit_cast(bf16x8, pw);
          const int koff = (kt * 32 + 16 * s2 + 8 * h) * 2;
          {
            bf16x8 vf = *(const bf16x8*)(sV + l32 * VROW + koff);
            o0 = MFMA32(vf, pf, o0);
            lacc = MFMA32(ones, pf, lacc);
          }
          {
            bf16x8 vf = *(const bf16x8*)(sV + (32 + l32) * VROW + koff);
            o1 = MFMA32(vf, pf, o1);
          }
        }
    }
  };

  AGLOAD(ka0, va0, TILE_OF(0));
  if (n_it > 1) { AGLOAD(kb0, vb0, TILE_OF(1)); }
  ASWRITE(ka0, va0, 0);
  if (n_it > 2) { AGLOAD(ka0, va0, TILE_OF(2)); }
  __syncthreads();
  for (int it = 0; it < n_it; it += 2) {
    if (it + 1 < n_it) { ASWRITE(kb0, vb0, 1); }
    if (it + 3 < n_it) { AGLOAD(kb0, vb0, TILE_OF(it + 3)); }
    __builtin_amdgcn_sched_barrier(0);
    compute(0, TILE_OF(it));
    __syncthreads();
    if (it + 1 < n_it) {
      if (it + 2 < n_it) { ASWRITE(ka0, va0, 0); }
      if (it + 4 < n_it) { AGLOAD(ka0, va0, TILE_OF(it + 4)); }
      __builtin_amdgcn_sched_barrier(0);
      compute(1, TILE_OF(it + 1));
      __syncthreads();
    }
  }
#undef AGLOAD
#undef ASWRITE
#undef TILE_OF

  float l_tot = lacc[0];
  if (hasSink) l_tot += __builtin_amdgcn_exp2f(sinkv * LOG2E - m_fix);
  float inv = 1.f / l_tot;
  int T = (mode == 3) ? (TLAT + b * 256 + (qpos - 4096)) : (b * 4096 + qpos);
  u16* od = p.O + (size_t)T * LDK + head16 * 64;
#pragma unroll
  for (int g = 0; g < 4; ++g) {
    int d0 = 8 * g + 4 * h;
    *(uint2*)(od + d0) = make_uint2(pack_bf16(o0[4 * g] * inv, o0[4 * g + 1] * inv), pack_bf16(o0[4 * g + 2] * inv, o0[4 * g + 3] * inv));
    *(uint2*)(od + 32 + d0) = make_uint2(pack_bf16(o1[4 * g] * inv, o1[4 * g + 1] * inv), pack_bf16(o1[4 * g + 2] * inv, o1[4 * g + 3] * inv));
  }
}

DI void run_gphase(const Params& p, int g, char* smem, int coff = 0) {
  using namespace pg8;
  LAS unsigned char* lds = (LAS unsigned char*)smem;
  const int layer = (g - 1) / 7, ph = (g - 1) % 7 + 1;
  const bool hasc = (g + 1 <= 23);
  const int cl = g / 7;
  const int bid = blockIdx.x, nb = gridDim.x;
  const float* xin_lat; const float* xin_ctx; float* xo_lat = p.out; float* xo_ctx = p.xctx;
  { const float* a_ = p.x; const float* c_ = p.ctx; asm volatile("" : "+s"(a_), "+s"(c_));
    float* b_ = p.out; float* d_ = p.xctx; asm volatile("" : "+s"(b_), "+s"(d_));
    xin_lat = (layer == 0) ? a_ : (const float*)b_; xin_ctx = (cl == 0) ? c_ : (const float*)d_; xo_lat = b_; xo_ctx = d_; }
  switch (ph) {
    case 1: {
      if (hasc) {
        OneUnit S; S.u.pm = bid & 3; S.u.pn = bid >> 2; S.valid = bid < 32;
        EpiQKV E; E.qkv = p.QKV; E.qkn = p.qk_norm + cl * 6 * 64; E.rope = p.rope; E.rowbase = TLAT;
        gemm_phase(lds, Gemm{p.H + (size_t)TLAT * LDK, p.wt_in + (size_t)cl * INW * LDK, DM}, S, E);
      }
      norm_dyn(p, layer, 0, 0, TLAT, &p.counters[32 + g + coff]);
    } break;
    case 2: {
      TileOrder S; S.init(64, 8, nb, bid, 0);
      EpiQKV E; E.qkv = p.QKV; E.qkn = p.qk_norm + layer * 6 * 64; E.rope = p.rope; E.rowbase = 0;
      gemm_phase(lds, Gemm{p.H, p.wt_in + (size_t)layer * INW * LDK, DM}, S, E);
      if (hasc)
        for (int i = bid; i < NAT_CTX; i += nb) attn_item(p, cl, NAT_LAT + i, smem);
    } break;
    case 3: {
      const int nctx = hasc ? 16 : 0;
      for (int it = grab(&p.counters[g + coff]); it < NAT_LAT + nctx; it = grab(&p.counters[g + coff])) {
        if (it < NAT_C) attn_item(p, layer, it, smem);
        else if (it < NAT_C + nctx) {
          int j = it - NAT_C;
          OneUnit S; S.u.pm = j & 3; S.u.pn = j >> 2; S.valid = true;
          EpiRes E; E.src = xin_ctx; E.dst = xo_ctx; E.gate = p.mod + ((size_t)cl * 5 + 4) * 6144 + 2 * 1024;
          gemm_phase(lds, Gemm{p.O + (size_t)TLAT * LDK, p.wt_out + (size_t)cl * DM * LDK, DM}, S, E);
        } else attn_item(p, layer, it - nctx, smem);
      }
    } break;
    case 4: {
      TileOrder S; S.init(64, 4, nb, bid, 0);
      Unit u0;
      for (int i = 0; S.next(i, u0); ++i) {
        OneUnit S1; S1.u = u0; S1.valid = true;
        EpiRes E; E.src = xin_lat; E.dst = xo_lat; E.gate = p.mod + ((size_t)layer * 5 + (u0.pm >> 4)) * 6144 + 2 * 1024;
        gemm_phase(lds, Gemm{p.O, p.wt_out + (size_t)layer * DM * LDK, DM}, S1, E);
      }
      if (hasc) norm_static(p, cl, 1, TLAT, TTOT);
    } break;
    case 5: {
      if (hasc) {
        OneUnit S; S.u.pm = bid & 3; S.u.pn = bid >> 2; S.valid = bid < 88;
        EpiGU E; E.act = p.ACT + (size_t)TLAT * LDF;
        gemm_phase(lds, Gemm{p.H + (size_t)TLAT * LDK, p.wt_gu + (size_t)cl * GUW * LDK, DM}, S, E);
      }
      norm_dyn(p, layer, 1, 0, TLAT, &p.counters[32 + g + coff]);
    } break;
    case 6: {
      if (hasc) {
        int j = (nb == 256) ? bid - 240 : bid;
        OneUnit S; S.u.pm = j & 3; S.u.pn = (j >> 2) & 3; S.valid = (j >= 0 && j < 16);
        EpiRes E; E.src = xo_ctx; E.dst = xo_ctx; E.gate = p.mod + ((size_t)cl * 5 + 4) * 6144 + 5 * 1024;
        gemm_phase(lds, Gemm{p.ACT + (size_t)TLAT * LDF, p.wt_down + (size_t)cl * DM * LDF, FFN}, S, E);
      }
      TileOrder S; S.init(64, 22, nb, bid, (hasc && nb == 256) ? 1 : 0);
      EpiGU E; E.act = p.ACT;
      gemm_phase(lds, Gemm{p.H, p.wt_gu + (size_t)layer * GUW * LDK, DM}, S, E);
    } break;
    case 7: {
      TileOrder S; S.init(64, 4, nb, bid, 0);
      Unit u0;
      for (int i = 0; S.next(i, u0); ++i) {
        OneUnit S1; S1.u = u0; S1.valid = true;
        EpiRes E; E.src = xo_lat; E.dst = xo_lat; E.gate = p.mod + ((size_t)layer * 5 + (u0.pm >> 4)) * 6144 + 5 * 1024;
        gemm_phase(lds, Gemm{p.ACT, p.wt_down + (size_t)layer * DM * LDF, FFN}, S1, E);
      }
      if (hasc) norm_static(p, cl, 0, TLAT, TTOT);
    } break;
  }
}

#define XB_XCNT(j)  (256  + 64 * (j))
#define XB_XSUB(j)  (1280 + 64 * (j))
#define XB_XGEN(j)  (2304 + 64 * (j))
#define XB_TOP      3328
#define XB_TOPGEN   3392
#define XCD_BAR_WORDS 3456
#define LAS __attribute__((address_space(3)))
DI unsigned xb_ld(unsigned* p) { return __hip_atomic_load(p, __ATOMIC_RELAXED, __HIP_MEMORY_SCOPE_AGENT); }
DI unsigned xb_add(unsigned* p, unsigned v) { return __hip_atomic_fetch_add(p, v, __ATOMIC_RELAXED, __HIP_MEMORY_SCOPE_AGENT); }
DI unsigned xb_xcc_id() { return (unsigned)__builtin_amdgcn_s_getreg((3 << 11) | 20) & 0xFu; }
struct XcdBarrier { unsigned* bar; unsigned x; volatile LAS unsigned* st; };
DI XcdBarrier xcd_barrier_post(unsigned* bar, volatile LAS unsigned* st) {
  XcdBarrier b; b.bar = bar; b.x = xb_xcc_id(); b.st = st;
  if (threadIdx.x == 0) (void)xb_add(&bar[XB_XCNT(b.x)], 1u);
  return b;
}
DI void xcd_barrier_complete(unsigned* bar, unsigned x, unsigned& nloc, unsigned& nx) {
  const unsigned G = gridDim.x;
  unsigned sum, cnt, mine;
  for (;;) {
    sum = 0u; cnt = 0u; mine = 0u;
#pragma unroll
    for (unsigned j = 0; j < 16; ++j) { const unsigned c = xb_ld(&bar[XB_XCNT(j)]); sum += c; cnt += (c > 0u) ? 1u : 0u; mine = (j == x) ? c : mine; }
    if (sum == G) break;
    __builtin_amdgcn_s_sleep(1);
  }
  nloc = mine > 0u ? mine : 1u; nx = cnt > 0u ? cnt : 1u;
}
DI void xcd_barrier(const XcdBarrier& b) {
  asm volatile("s_waitcnt vmcnt(0)" ::: "memory");
  __syncthreads();
  if (threadIdx.x == 0) {
    unsigned* bar = b.bar;
    unsigned bx = b.x;
    asm volatile("" : "+s"(bx));
    __builtin_amdgcn_s_waitcnt(0);
    unsigned nloc = b.st[0], nx = b.st[1];
    if (nloc == 0u) { xcd_barrier_complete(bar, bx, nloc, nx); b.st[0] = nloc; b.st[1] = nx; }
    const unsigned old = xb_add(&bar[XB_XSUB(bx)], 1u);
    const unsigned gen = old / nloc;
    if (old + 1u == (gen + 1u) * nloc) {
      __builtin_amdgcn_fence(__ATOMIC_RELEASE, "agent");
      asm volatile("s_waitcnt vmcnt(0)" ::: "memory");
      const unsigned og = xb_add(&bar[XB_TOP], 1u);
      const unsigned tg = og / nx;
      if (og + 1u == (tg + 1u) * nx) xb_add(&bar[XB_TOPGEN], 1u);
      else { while (xb_ld(&bar[XB_TOPGEN]) == tg) __builtin_amdgcn_s_sleep(1); }
      __builtin_amdgcn_fence(__ATOMIC_ACQUIRE, "agent");
      xb_add(&bar[XB_XGEN(bx)], 1u);
      asm volatile("s_waitcnt vmcnt(0)" ::: "memory");
    } else {
      while (xb_ld(&bar[XB_XGEN(bx)]) == gen) __builtin_amdgcn_s_sleep(1);
      __builtin_amdgcn_fence(__ATOMIC_ACQUIRE, "agent");
      asm volatile("s_waitcnt vmcnt(0)" ::: "memory");
    }
  }
  __syncthreads();
}


__global__ void __launch_bounds__(512, 2) fwd_megakernel(Params p) {
  extern __shared__ __attribute__((aligned(16))) unsigned char dsm[];
  char* smem = (char*)dsm;
  cg::grid_group grid = cg::this_grid();
  if (threadIdx.x == 0) *(uint4*)(dsm + 131072) = make_uint4(0u, 0u, 0u, 0u);
  __syncthreads();
  XcdBarrier xb = xcd_barrier_post(p.counters + 1024, (volatile LAS unsigned*)(dsm + 131072));
  phase0(p, smem);
  grid.sync();
  norm_static(p, 0, 0, TLAT, TTOT);
  xcd_barrier(xb);
  for (int g = 1; g <= 7 * NLAYER; ++g) {
    run_gphase(p, g, smem);
#ifdef PROBE_DOUBLE
    if ((g - 1) % 7 + 1 == PROBE_DOUBLE) { xcd_barrier(xb); run_gphase(p, g, smem, 100); }
#endif
    if (g < 7 * NLAYER) xcd_barrier(xb);
  }
}

extern "C" void kernel_launch(void* const* d_in, const int* in_sizes, int n_in, void* d_out, int out_size, void* d_ws,
                              size_t ws_size, hipStream_t stream) {
  Params p{};
  p.x = (const float*)d_in[0]; p.c = (const float*)d_in[1]; p.ctx = (const float*)d_in[2]; p.c_ctx = (const float*)d_in[3];
  p.w_mod = (const float*)d_in[4]; p.b_mod = (const float*)d_in[5]; p.norm_attn = (const float*)d_in[6];
  p.norm_ffn = (const float*)d_in[7]; p.w_in = (const float*)d_in[8]; p.qk_norm = (const float*)d_in[9];
  p.sink = (const float*)d_in[10]; p.rpb = (const float*)d_in[11]; p.w_out = (const float*)d_in[12];
  p.w_gate = (const float*)d_in[13]; p.w_up = (const float*)d_in[14]; p.w_down = (const float*)d_in[15];
  p.out = (float*)d_out;
  char* w = (char*)d_ws;
  size_t off = 0;
  auto take = [&](size_t bytes) { char* r = w + off; off += (bytes + 255) & ~(size_t)255; return r; };
  p.counters = (unsigned*)take(4096 + XCD_BAR_WORDS * 4);
  p.wt_in = (u16*)take((size_t)NLAYER * INW * LDK * 2);
  p.wt_out = (u16*)take((size_t)NLAYER * DM * LDK * 2);
  p.wt_gu = (u16*)take((size_t)NLAYER * GUW * LDK * 2);
  p.wt_down = (u16*)take((size_t)NLAYER * DM * LDF * 2);
  p.H = (u16*)take((size_t)TTOT * LDK * 2);
  p.mod = (float*)take((size_t)NLAYER * 5 * 6144 * 4);
  p.xctx = (float*)take((size_t)TCTX * DM * 4);
  p.rope = (float*)take((size_t)SEQL * 32 * 2 * 4);
  p.bounds = (float*)take(256);
  p.QKV = (u16*)take((size_t)NBATCH * 32 * LTOT * 64 * 2);
  p.O = (u16*)take((size_t)TTOT * LDK * 2);
  p.ACT = p.QKV;

  hipMemsetAsync(p.counters, 0, 4096 + XCD_BAR_WORDS * 4, stream);

  static int grid_blocks = 0;
  if (!grid_blocks) {
    int dev = 0, cus = 0, per_cu = 0;
    hipGetDevice(&dev);
    hipDeviceGetAttribute(&cus, hipDeviceAttributeMultiprocessorCount, dev);
    hipFuncSetAttribute((const void*)fwd_megakernel, hipFuncAttributeMaxDynamicSharedMemorySize, DYN_LDS);
    hipOccupancyMaxActiveBlocksPerMultiprocessor(&per_cu, fwd_megakernel, NTHR, DYN_LDS);
    if (per_cu > 1) per_cu = 1;
    if (per_cu < 1) per_cu = 1;
    grid_blocks = cus * per_cu;
  }
  void* args[] = {&p};
  hipError_t e = hipLaunchCooperativeKernel((void*)fwd_megakernel, dim3(grid_blocks), dim3(NTHR), args, DYN_LDS, stream);
  if (e != hipSuccess) fprintf(stderr, "cooperative launch failed: %s (grid %d)\n", hipGetErrorString(e), grid_blocks);
}
```

```cpp
#include <hip/hip_runtime.h>
#include <hip/hip_cooperative_groups.h>
#include <cstdio>
namespace cg = cooperative_groups;

typedef unsigned short u16;
typedef __attribute__((ext_vector_type(8))) short bf16x8;
typedef __attribute__((ext_vector_type(16))) float f32x16;
typedef __attribute__((ext_vector_type(4))) float f32x4;
typedef __attribute__((ext_vector_type(2))) float f32x2;
typedef __attribute__((ext_vector_type(2))) __bf16 bf16x2_t;
#define DI __device__ __forceinline__
#define LAS __attribute__((address_space(3)))
#define MFMA32(a, b, c) __builtin_amdgcn_mfma_f32_32x32x16_bf16((a), (b), (c), 0, 0, 0)

constexpr int DM = 1024, NBATCH = 4, SEQL = 4096, CTXL = 256, LTOT = 4352;
constexpr int TLAT = NBATCH * SEQL, TCTX = NBATCH * CTXL, TTOT = TLAT + TCTX;
constexpr int NLAYER = 4, INW = 2048, FFN = 2816, GUW = 2 * FFN;
constexpr int LDK = DM, LDF = FFN;
constexpr int NTHR = 512;
constexpr int DYN_LDS = 131072 + 64;
constexpr float EPSV = 1e-6f;
constexpr float LOG2E = 1.4426950408889634f;

struct Params {
  const float *x, *c, *ctx, *c_ctx, *w_mod, *b_mod, *norm_attn, *norm_ffn, *w_in, *qk_norm, *sink, *rpb,
              *w_out, *w_gate, *w_up, *w_down;
  float* out;
  u16 *wt_in, *wt_out, *wt_gu, *wt_down, *H, *QKV, *O, *ACT;
  float *mod, *xctx, *rope, *bounds;
  unsigned* counters;
};

DI unsigned pack_bf16(float a, float b) {
  f32x2 v = {a, b};
  bf16x2_t r = __builtin_convertvector(v, bf16x2_t);
  return __builtin_bit_cast(unsigned, r);
}
DI u16 f2bf(float a) { return (u16)(pack_bf16(a, 0.f) & 0xffffu); }
DI int tidx() { int t = threadIdx.x; asm volatile("" : "+v"(t)); return t; }
DI int crow(int r, int h) { return (r & 3) + 8 * (r >> 2) + 4 * h; }

DI int grab(unsigned* ctr) {
  __shared__ int s_grab;
  if (threadIdx.x == 0) s_grab = (int)atomicAdd(ctr, 1u);
  __syncthreads();
  int v = s_grab;
  __syncthreads();
  return v;
}

DI void phase0(const Params& p, char* smem) {
  const int tid = tidx();
  constexpr int NWP = NLAYER * 2880 / 2, NMOD = NLAYER * 96, NROPE = 256, NBND = 1;
  const float* w_in_ = p.w_in; const float* w_out_ = p.w_out; const float* w_gate_ = p.w_gate;
  const float* w_up_ = p.w_up; const float* w_down_ = p.w_down;
  asm volatile("" : "+v"(w_in_), "+v"(w_out_), "+v"(w_gate_), "+v"(w_up_), "+v"(w_down_));
  {
    const int half = tid >> 8, t = tid & 255;
    float* tile = (float*)(smem + half * 16640);
    const float* src; int N, k0, n0, Kd, up, kind; u16* dst;
    const float* nsrc = nullptr; int nN = 0, nk0 = 0, nn0 = 0, nKd = 0, nup = 0, nkind = 0; u16* ndst = nullptr;
    float4 cur[4], nxt[4];
#define WDECODE(item_, src_, N_, k0_, n0_, Kd_, up_, kind_, dst_)                                                              \
    {                                                                                                                          \
      const int it2_ = (item_) * 2 + half; const int layer_ = it2_ / 2880; int idx_ = it2_ % 2880; up_ = 0;                    \
      if (idx_ < 512) { kind_ = 0; k0_ = (idx_ >> 5) * 64; n0_ = (idx_ & 31) * 64; src_ = w_in_ + (size_t)layer_ * DM * INW; N_ = INW; dst_ = p.wt_in + (size_t)layer_ * INW * DM; Kd_ = DM; } \
      else if (idx_ < 768) { idx_ -= 512; kind_ = 0; k0_ = (idx_ >> 4) * 64; n0_ = (idx_ & 15) * 64; src_ = w_out_ + (size_t)layer_ * DM * DM; N_ = DM; dst_ = p.wt_out + (size_t)layer_ * DM * DM; Kd_ = DM; } \
      else if (idx_ < 2176) { idx_ -= 768; up_ = idx_ >= 704; if (up_) idx_ -= 704; kind_ = 1; k0_ = (idx_ / 44) * 64; n0_ = (idx_ % 44) * 64; \
        src_ = (up_ ? w_up_ : w_gate_) + (size_t)layer_ * DM * FFN; N_ = FFN; dst_ = p.wt_gu + (size_t)layer_ * GUW * DM; Kd_ = DM; } \
      else { idx_ -= 2176; kind_ = 0; k0_ = (idx_ >> 4) * 64; n0_ = (idx_ & 15) * 64; src_ = w_down_ + (size_t)layer_ * FFN * DM; N_ = DM; dst_ = p.wt_down + (size_t)layer_ * DM * FFN; Kd_ = FFN; } \
    }
#define WLOAD(v_, src_, N_, k0_, n0_)                                                                                          \
    _Pragma("unroll") for (int ps = 0; ps < 4; ++ps) {                                                                         \
      int kk = (t >> 4) + 16 * ps, nn = (t & 15) * 4;                                                                          \
      v_[ps] = *(const float4*)(src_ + (size_t)(k0_ + kk) * N_ + n0_ + nn);                                                    \
    }
    int item = blockIdx.x;
    if (item < NWP) { WDECODE(item, src, N, k0, n0, Kd, up, kind, dst); WLOAD(cur, src, N, k0, n0); }
    for (; item < NWP; item += gridDim.x) {
      const int nitem = item + gridDim.x;
      if (nitem < NWP) { WDECODE(nitem, nsrc, nN, nk0, nn0, nKd, nup, nkind, ndst); WLOAD(nxt, nsrc, nN, nk0, nn0); }
#pragma unroll
      for (int ps = 0; ps < 4; ++ps) {
        int kk = (t >> 4) + 16 * ps, nn = (t & 15) * 4;
        tile[kk * 65 + nn] = cur[ps].x; tile[kk * 65 + nn + 1] = cur[ps].y; tile[kk * 65 + nn + 2] = cur[ps].z; tile[kk * 65 + nn + 3] = cur[ps].w;
      }
      __syncthreads();
      {
        int n = t >> 2, kc = (t & 3) * 16;
        unsigned w[8];
#pragma unroll
        for (int j = 0; j < 8; ++j) w[j] = pack_bf16(tile[(kc + 2 * j) * 65 + n], tile[(kc + 2 * j + 1) * 65 + n]);
        int col = n0 + n;
        int row = kind ? ((col >> 7) * 256 + up * 128 + (col & 127)) : col;
        uint4* d = (uint4*)(dst + (size_t)row * Kd + k0 + kc);
        d[0] = make_uint4(w[0], w[1], w[2], w[3]);
        d[1] = make_uint4(w[4], w[5], w[6], w[7]);
      }
      __syncthreads();
#pragma unroll
      for (int ps = 0; ps < 4; ++ps) cur[ps] = nxt[ps];
      src = nsrc; N = nN; k0 = nk0; n0 = nn0; Kd = nKd; up = nup; kind = nkind; dst = ndst;
    }
#undef WDECODE
#undef WLOAD
  }
  for (int item = NWP + blockIdx.x; item < NWP + NMOD + NROPE + NBND; item += gridDim.x) {
    if (false) {
    } else if (item < NWP + NMOD) {
      int it = item - NWP, layer = it / 96, cg0 = (it % 96) * 64;
      float* sc = (float*)smem;
      float* red = sc + 5 * 1024;
      for (int e = tid; e < 5 * 1024; e += NTHR) {
        int mb = e >> 10, k = e & 1023;
        float v = (mb < 4) ? p.c[mb * 1024 + k] : p.c_ctx[k];
        sc[e] = v / (1.f + __expf(-v));
      }
      __syncthreads();
      int col = cg0 + (tid & 63), kq = tid >> 6;
      const float* w = p.w_mod + (size_t)layer * DM * 6144 + col;
      float a0 = 0, a1 = 0, a2 = 0, a3 = 0, a4 = 0;
#pragma unroll 32
      for (int k = kq * 128; k < kq * 128 + 128; ++k) {
        float wv = w[(size_t)k * 6144];
        a0 += sc[k] * wv; a1 += sc[1024 + k] * wv; a2 += sc[2048 + k] * wv; a3 += sc[3072 + k] * wv; a4 += sc[4096 + k] * wv;
      }
      int c64 = tid & 63;
      red[(kq * 5 + 0) * 64 + c64] = a0; red[(kq * 5 + 1) * 64 + c64] = a1; red[(kq * 5 + 2) * 64 + c64] = a2;
      red[(kq * 5 + 3) * 64 + c64] = a3; red[(kq * 5 + 4) * 64 + c64] = a4;
      __syncthreads();
      for (int e = tid; e < 5 * 64; e += NTHR) {
        int mb = e >> 6, cc = e & 63;
        float s = 0.f;
#pragma unroll
        for (int q = 0; q < 8; ++q) s += red[(q * 5 + mb) * 64 + cc];
        p.mod[((size_t)layer * 5 + mb) * 6144 + cg0 + cc] = s + p.b_mod[layer * 6144 + cg0 + cc];
      }
      __syncthreads();
    } else if (item >= NWP + NMOD + NROPE) {
      unsigned* mx = (unsigned*)smem;
      for (int e = tid; e < NLAYER * 10; e += NTHR) mx[e] = 0u;
      __syncthreads();
      for (int e = tid; e < NLAYER * 6 * 64; e += NTHR) atomicMax(&mx[(e / 384) * 10 + (e % 384) / 64], __float_as_uint(fabsf(p.qk_norm[e])));
      for (int e = tid; e < NLAYER * 4 * 465; e += NTHR) atomicMax(&mx[(e / 1860) * 10 + 6 + (e % 1860) / 465], __float_as_uint(fabsf(p.rpb[e])));
      __syncthreads();
      if (tid < NLAYER * 8) {
        int l = tid >> 3, j = tid & 7; float v = 0.f;
        if (j < 3) v = 0.125f * LOG2E * 64.f * 1.02f * __uint_as_float(mx[l * 10 + 2 * j]) * __uint_as_float(mx[l * 10 + 2 * j + 1]);
        else if (j >= 4) v = LOG2E * __uint_as_float(mx[l * 10 + 6 + (j - 4)]);
        p.bounds[tid] = v;
      }
      __syncthreads();
    } else {
      int e = (item - NWP - NMOD) * NTHR + tid;
      int t = e >> 5, pi = e & 31;
      float pos = (pi < 16) ? (float)(t >> 6) : (float)(t & 63);
      float inv = exp2f(-(float)(pi & 15) * (13.287712379549449f / 16.0f));
      float ang = pos * inv;
      p.rope[2 * e] = __cosf(ang);
      p.rope[2 * e + 1] = __sinf(ang);
    }
  }
}

DI const float* xrow_src(const Params& p, int layer, int t) {
  const float* a = p.x; const float* b = p.out; const float* c = p.ctx; const float* d = p.xctx;
  asm volatile("" : "+v"(a), "+v"(b), "+v"(c), "+v"(d));
  if (t < TLAT) return (layer == 0 ? a : b) + (size_t)t * DM;
  return (layer == 0 ? c : d) + (size_t)(t - TLAT) * DM;
}
DI float* xrow_dst(const Params& p, int t) {
  float* b = p.out; float* d = p.xctx;
  asm volatile("" : "+v"(b), "+v"(d));
  if (t < TLAT) return b + (size_t)t * DM;
  return d + (size_t)(t - TLAT) * DM;
}
DI int mb_of(int t) { return t < TLAT ? (t >> 12) : 4; }

DI void norm_row(const Params& p, int layer, int which, int t, int lane) {
  const float* g = (which ? p.norm_ffn : p.norm_attn) + layer * DM;
  const float* xr = which ? (const float*)xrow_dst(p, t) : xrow_src(p, layer, t);
  const float* md = p.mod + ((size_t)layer * 5 + mb_of(t)) * 6144 + (which ? 3 * 1024 : 0);
  float4 v[4];
  float ss = 0.f;
#pragma unroll
  for (int j = 0; j < 4; ++j) {
    v[j] = *(const float4*)(xr + lane * 4 + 256 * j);
    ss += v[j].x * v[j].x + v[j].y * v[j].y + v[j].z * v[j].z + v[j].w * v[j].w;
  }
#pragma unroll
  for (int o = 32; o >= 1; o >>= 1) ss += __shfl_xor(ss, o);
  float r = rsqrtf(ss * (1.f / 1024.f) + EPSV);
#pragma unroll
  for (int j = 0; j < 4; ++j) {
    int col = lane * 4 + 256 * j;
    float4 gg = *(const float4*)(g + col);
    float4 sh = *(const float4*)(md + col);
    float4 sc = *(const float4*)(md + 1024 + col);
    float o0 = v[j].x * r * gg.x * (1.f + sc.x) + sh.x;
    float o1 = v[j].y * r * gg.y * (1.f + sc.y) + sh.y;
    float o2 = v[j].z * r * gg.z * (1.f + sc.z) + sh.z;
    float o3 = v[j].w * r * gg.w * (1.f + sc.w) + sh.w;
    *(uint2*)(p.H + (size_t)t * LDK + col) = make_uint2(pack_bf16(o0, o1), pack_bf16(o2, o3));
  }
}
template <int R>
DI void norm_rows(const Params& p, int layer, int which, int t0, int tstep, int lane) {
  const float* g = (which ? p.norm_ffn : p.norm_attn) + layer * DM;
  const float* md = p.mod + ((size_t)layer * 5 + mb_of(t0)) * 6144 + (which ? 3 * 1024 : 0);
  float4 v[R][4];
  float ss[R];
#pragma unroll
  for (int r = 0; r < R; ++r) {
    const float* xr = which ? (const float*)xrow_dst(p, t0 + r * tstep) : xrow_src(p, layer, t0 + r * tstep);
#pragma unroll
    for (int j = 0; j < 4; ++j) v[r][j] = *(const float4*)(xr + lane * 4 + 256 * j);
  }
#pragma unroll
  for (int r = 0; r < R; ++r) {
    ss[r] = 0.f;
#pragma unroll
    for (int j = 0; j < 4; ++j) ss[r] += v[r][j].x * v[r][j].x + v[r][j].y * v[r][j].y + v[r][j].z * v[r][j].z + v[r][j].w * v[r][j].w;
  }
#pragma unroll
  for (int o = 32; o >= 1; o >>= 1)
#pragma unroll
    for (int r = 0; r < R; ++r) ss[r] += __shfl_xor(ss[r], o);
#pragma unroll
  for (int r = 0; r < R; ++r) ss[r] = rsqrtf(ss[r] * (1.f / 1024.f) + EPSV);
#pragma unroll
  for (int j = 0; j < 4; ++j) {
    int col = lane * 4 + 256 * j;
    float4 gg = *(const float4*)(g + col);
    float4 sh = *(const float4*)(md + col);
    float4 sc = *(const float4*)(md + 1024 + col);
    float m0 = gg.x * (1.f + sc.x), m1 = gg.y * (1.f + sc.y), m2 = gg.z * (1.f + sc.z), m3 = gg.w * (1.f + sc.w);
#pragma unroll
    for (int r = 0; r < R; ++r)
      *(uint2*)(p.H + (size_t)(t0 + r * tstep) * LDK + col) =
          make_uint2(pack_bf16(v[r][j].x * ss[r] * m0 + sh.x, v[r][j].y * ss[r] * m1 + sh.y), pack_bf16(v[r][j].z * ss[r] * m2 + sh.z, v[r][j].w * ss[r] * m3 + sh.w));
  }
}
DI void norm_static(const Params& p, int layer, int which, int row0, int row1) {
  const int tid = tidx(), lane = tid & 63, wid = tid >> 6;
  for (int t = row0 + blockIdx.x * 8 + wid; t < row1; t += gridDim.x * 8) norm_row(p, layer, which, t, lane);
}
DI void norm_dyn(const Params& p, int layer, int which, int row0, int row1, unsigned* ctr) {
  const int tid = tidx(), lane = tid & 63, wid = tid >> 6;
  const int nchunk = (row1 - row0) >> 5;
  while (true) {
    int ch = grab(ctr);
    if (ch >= nchunk) break;
    norm_rows<4>(p, layer, which, row0 + ch * 32 + wid, 8, lane);
  }
}

namespace pg8 {
typedef unsigned short bf16_t;
constexpr int BM = 256, BK = 64, HALF = 128, HTB = HALF * BK * 2, STAGE_BYTES = 8 * HTB, NXCD = 8, WGM = 8;
DI int lds_byte(int r, int c) { const int st = (r >> 4) * 2 + (c >> 5), rr = r & 15, cc = c & 31, ob = rr * 64 + cc * 2; return st * 1024 + (ob ^ (((ob >> 9) & 1) << 5)); }
DI void stage_rc(int b, int& R, int& C) { const int st = b / 1024, sb = b % 1024, swz = sb ^ (((sb >> 9) & 1) << 5); R = (st >> 1) * 16 + swz / 64; C = (st & 1) * 32 + (swz % 64) / 2; }
DI int perm32(int rho) { const int n = rho >> 4, i = rho & 15; return 8 * (i >> 2) + 4 * n + (i & 3); }
struct Unit { int pm, pn; };
struct Gemm { const bf16_t* A; const bf16_t* Bt; int K; };

struct TileOrder {
  int nM, nN, nwg, G, c, remap;
  DI void init(int nM_, int nN_, int G_, int c_, int remap_) { nM = nM_; nN = nN_; nwg = nM * nN; G = G_; c = c_; remap = remap_; }
  DI bool next(int i, Unit& u) const {
    long L = (long)i * G + c;
    if (remap) {
      if (c >= 240) { if (i >= 3) return false; }
      else if (c >= 128 && c < 144 && i == 5) L = 4L * G + (c + 112);
      else if (c >= 144 && c < 160 && i == 5) L = 3L * G + (c + 96);
    }
    if (L >= nwg) return false;
    int wgid = (int)L; { const int q = nwg / NXCD, r = nwg % NXCD, xcd = wgid % NXCD, off = wgid / NXCD; wgid = (xcd < r ? xcd * (q + 1) : r * (q + 1) + (xcd - r) * q) + off; }
    const int nig = WGM * nN, gid = wgid / nig, fm = gid * WGM, gsz = (nM - fm) < WGM ? (nM - fm) : WGM;
    u.pm = fm + ((wgid % nig) % gsz); u.pn = (wgid % nig) / gsz; return true;
  }
};
struct OneUnit {
  Unit u; bool valid;
  DI bool next(int i, Unit& o) const { if (i != 0 || !valid) return false; o = u; return true; }
};

template <class Epi, class Sched>
DI void gemm_phase(LAS unsigned char* lds, const Gemm g, const Sched& S, const Epi& E) {
  const int tid = tidx(), wid = __builtin_amdgcn_readfirstlane(tid >> 6), lane = tid & 63, wr = wid >> 2, wc = wid & 3, fr = lane & 15, fq = lane >> 4;
  int K = g.K; asm volatile("" : "+s"(K));
  const int nt = K / BK;
  unsigned voffA[2], voffB[2];
#pragma unroll
  for (int i = 0; i < 2; ++i) {
    int R, C; stage_rc(tid * 16 + i * 8192, R, C);
    int Rb = R;
    if (Epi::BMAP == 1) Rb = (R & ~31) + perm32(R & 31);
    if (Epi::BMAP == 2) Rb = 64 * (R >> 5) + perm32(R & 31);
    voffA[i] = (unsigned)(R * K + C) * 2u; voffB[i] = (unsigned)(Rb * K + C) * 2u;
  }
  const size_t kstep = (size_t)(BK * 2);
  const size_t hstep = (size_t)HALF * K * 2;
  const size_t hstepB = (Epi::BMAP == 2) ? (size_t)32 * K * 2 : hstep;
  const size_t tstep = 2 * hstep;
  const unsigned ldsw = (unsigned)wid * 1024u;
  const int aoff = lds_byte(wr * 64 + fr, fq * 8), boff = lds_byte(wc * 32 + fr, fq * 8);
#define PG8_SA(b, h) (((b) * 2 + (h)) * HTB)
#define PG8_SB(b, h) ((4 + (b) * 2 + (h)) * HTB)
#define PG8_STAGE(bufoff, gbase, voff) do { _Pragma("unroll") for (int _i = 0; _i < 2; ++_i) \
    __builtin_amdgcn_global_load_lds((const unsigned*)((const char*)(gbase) + (voff)[_i]), (LAS unsigned*)(lds + (bufoff) + ldsw + _i * 8192), 16, 0, 0); } while (0)
#define PG8_LDA(dst, b, h) do { _Pragma("unroll") for (int m = 0; m < 4; ++m) _Pragma("unroll") for (int k = 0; k < 2; ++k) dst[m][k] = *(const LAS bf16x8*)(lds + PG8_SA(b, h) + aoff + m * 2048 + k * 1024); } while (0)
#define PG8_LDB(dst, b, h) do { _Pragma("unroll") for (int n = 0; n < 2; ++n) _Pragma("unroll") for (int k = 0; k < 2; ++k) dst[n][k] = *(const LAS bf16x8*)(lds + PG8_SB(b, h) + boff + n * 2048 + k * 1024); } while (0)
#define PG8_MMA(ai, bj, At, Bt) do { __builtin_amdgcn_s_setprio(1); _Pragma("unroll") for (int m = 0; m < 4; ++m) _Pragma("unroll") for (int n = 0; n < 2; ++n) _Pragma("unroll") for (int k = 0; k < 2; ++k) \
    acc[ai][bj][m][n] = __builtin_amdgcn_mfma_f32_16x16x32_bf16(Bt[n][k], At[m][k], acc[ai][bj][m][n], 0, 0, 0); __builtin_amdgcn_s_setprio(0); } while (0)
#define PG8_WAIT_V(n) asm volatile("s_waitcnt vmcnt(" #n ")" ::: "memory")
#define PG8_WAIT_L(n) asm volatile("s_waitcnt lgkmcnt(" #n ")" ::: "memory")
#define PG8_BAR __builtin_amdgcn_s_barrier()
#define PG8_SCHED __builtin_amdgcn_sched_barrier(0)
  Unit cur, nxt; int ui = 0;
  if (!S.next(0, cur)) return;
  f32x4 acc[2][2][4][2];
#pragma unroll
  for (int a = 0; a < 2; ++a)
#pragma unroll
    for (int b = 0; b < 2; ++b)
#pragma unroll
      for (int m = 0; m < 4; ++m)
#pragma unroll
        for (int n = 0; n < 2; ++n) acc[a][b][m][n] = (f32x4){0.f, 0.f, 0.f, 0.f};
  bf16x8 At[4][2], B0[2][2], B1[2][2];
  const char* cA = (const char*)g.A + (size_t)cur.pm * tstep; const char* cB = (const char*)g.Bt + (size_t)cur.pn * tstep;
  PG8_STAGE(PG8_SB(0, 0), cB, voffB); PG8_STAGE(PG8_SA(0, 0), cA, voffA); PG8_STAGE(PG8_SB(0, 1), cB + hstepB, voffB); PG8_STAGE(PG8_SA(0, 1), cA + hstep, voffA);
  if (wr == 1) PG8_BAR;
  PG8_WAIT_V(4); PG8_BAR;
  PG8_STAGE(PG8_SB(1, 0), cB + kstep, voffB); PG8_STAGE(PG8_SA(1, 0), cA + kstep, voffA); PG8_STAGE(PG8_SB(1, 1), cB + hstepB + kstep, voffB);
  PG8_WAIT_V(6); PG8_BAR;
  for (;;) {
    const bool has_next = S.next(ui + 1, nxt);
    const char* nA = has_next ? (const char*)g.A + (size_t)nxt.pm * tstep : cA; const char* nB = has_next ? (const char*)g.Bt + (size_t)nxt.pn * tstep : cB;
    for (int t = 0; t < nt; t += 2) {
      const bool last = (t == nt - 2);
      const char* a1 = cA + (size_t)(t + 1) * kstep;
      const char* a2 = last ? nA : cA + (size_t)(t + 2) * kstep; const char* b2 = last ? nB : cB + (size_t)(t + 2) * kstep;
      const char* a3 = a2 + kstep; const char* b3 = b2 + kstep;
      PG8_LDB(B0, 0, 0); PG8_SCHED; PG8_LDA(At, 0, 0); PG8_STAGE(PG8_SA(1, 1), a1 + hstep, voffA);
      PG8_WAIT_L(8); PG8_BAR; PG8_WAIT_L(0); PG8_MMA(0, 0, At, B0); PG8_BAR; PG8_SCHED;
      PG8_LDB(B1, 0, 1); PG8_STAGE(PG8_SB(0, 0), b2, voffB);
      PG8_BAR; PG8_WAIT_L(0); PG8_MMA(0, 1, At, B1); PG8_BAR;
      PG8_LDA(At, 0, 1); PG8_STAGE(PG8_SA(0, 0), a2, voffA);
      PG8_BAR; PG8_WAIT_L(0); PG8_MMA(1, 0, At, B0); PG8_BAR; PG8_SCHED;
      PG8_STAGE(PG8_SB(0, 1), b2 + hstepB, voffB);
      PG8_WAIT_V(6); PG8_BAR; PG8_MMA(1, 1, At, B1); PG8_BAR;
      PG8_LDB(B0, 1, 0); PG8_SCHED; PG8_LDA(At, 1, 0); PG8_STAGE(PG8_SA(0, 1), a2 + hstep, voffA);
      PG8_WAIT_L(8); PG8_BAR; PG8_WAIT_L(0); PG8_MMA(0, 0, At, B0); PG8_BAR; PG8_SCHED;
      PG8_LDB(B1, 1, 1); PG8_STAGE(PG8_SB(1, 0), b3, voffB);
      PG8_BAR; PG8_WAIT_L(0); PG8_MMA(0, 1, At, B1); PG8_BAR;
      PG8_LDA(At, 1, 1); PG8_STAGE(PG8_SA(1, 0), a3, voffA);
      PG8_BAR; PG8_WAIT_L(0); PG8_MMA(1, 0, At, B0); PG8_BAR; PG8_SCHED;
      PG8_STAGE(PG8_SB(1, 1), b3 + hstepB, voffB);
      PG8_WAIT_V(6); PG8_BAR; PG8_MMA(1, 1, At, B1); PG8_BAR;
    }
    E(acc, cur, wr, wc, fr, fq);
    if (!has_next) break;
#pragma unroll
    for (int a = 0; a < 2; ++a)
#pragma unroll
      for (int b = 0; b < 2; ++b)
#pragma unroll
        for (int m = 0; m < 4; ++m)
#pragma unroll
          for (int n = 0; n < 2; ++n) acc[a][b][m][n] = (f32x4){0.f, 0.f, 0.f, 0.f};
    cur = nxt; cA = nA; cB = nB; ++ui;
  }
  PG8_WAIT_V(0);
  if (wr == 0) PG8_BAR;
  PG8_BAR;
#undef PG8_SA
#undef PG8_SB
#undef PG8_STAGE
#undef PG8_LDA
#undef PG8_LDB
#undef PG8_MMA
#undef PG8_WAIT_V
#undef PG8_WAIT_L
#undef PG8_BAR
#undef PG8_SCHED
}

struct EpiRes {
  static constexpr int BMAP = 0;
  const float* src; float* dst; const float* gate;
  DI void operator()(const f32x4 (&acc)[2][2][4][2], const Unit& u, int wr, int wc, int fr, int fq) const {
    asm volatile("" ::: "memory");
    const int row0 = u.pm * BM + wr * 64 + fr, col0 = u.pn * BM + wc * 32 + 4 * fq;
    f32x4 gv[2][2];
#pragma unroll
    for (int bj = 0; bj < 2; ++bj)
#pragma unroll
      for (int n = 0; n < 2; ++n) gv[bj][n] = *(const f32x4*)(gate + col0 + bj * HALF + n * 16);
#pragma unroll
    for (int ai = 0; ai < 2; ++ai)
#pragma unroll
      for (int m = 0; m < 4; ++m) {
        const size_t ro = (size_t)(row0 + ai * HALF + m * 16) * DM + col0;
#pragma unroll
        for (int bj = 0; bj < 2; ++bj)
#pragma unroll
          for (int n = 0; n < 2; ++n) {
            f32x4 s = *(const f32x4*)(src + ro + bj * HALF + n * 16);
            *(f32x4*)(dst + ro + bj * HALF + n * 16) = s + gv[bj][n] * acc[ai][bj][m][n];
          }
      }
  }
};
struct EpiGU {
  static constexpr int BMAP = 1;
  u16* act;
  DI void operator()(const f32x4 (&acc)[2][2][4][2], const Unit& u, int wr, int wc, int fr, int fq) const {
    asm volatile("" ::: "memory");
    const int row0 = u.pm * BM + wr * 64 + fr, col0 = u.pn * HALF + wc * 32 + 8 * fq;
#pragma unroll
    for (int ai = 0; ai < 2; ++ai)
#pragma unroll
      for (int m = 0; m < 4; ++m) {
        float a[8];
#pragma unroll
        for (int n = 0; n < 2; ++n)
#pragma unroll
          for (int e = 0; e < 4; ++e) {
            float gte = acc[ai][0][m][n][e], up = acc[ai][1][m][n][e];
            a[n * 4 + e] = gte * __builtin_amdgcn_rcpf(1.f + __builtin_amdgcn_exp2f(-gte * LOG2E)) * up;
          }
        *(uint4*)(act + (size_t)(row0 + ai * HALF + m * 16) * FFN + col0) =
            make_uint4(pack_bf16(a[0], a[1]), pack_bf16(a[2], a[3]), pack_bf16(a[4], a[5]), pack_bf16(a[6], a[7]));
      }
  }
};
struct EpiQKV {
  static constexpr int BMAP = 2;
  u16* qkv; const float* qkn; const float* rope; int rowbase;
  DI void operator()(const f32x4 (&acc)[2][2][4][2], const Unit& u, int wr, int wc, int fr, int fq) const {
    asm volatile("" ::: "memory");
    const int chunk = u.pn * 4 + wc;
    const bool isV = (chunk == 8 || chunk == 9 || (chunk >= 18 && chunk <= 21) || chunk >= 30);
    int gi = 0;
    if (chunk < 6) gi = 0; else if (chunk < 8) gi = 1; else if (chunk < 14) gi = 2; else if (chunk < 18) gi = 3;
    else if (chunk < 28) gi = 4; else gi = 5;
    const bool ropeT = (gi == 0 || gi == 1 || gi == 4 || gi == 5) && rowbase == 0;
    const float* gam = qkn + gi * 64;
    const float qs = (gi == 0 || gi == 2 || gi == 4) ? 0.125f * LOG2E : 1.f;
    f32x4 g4[2][2];
#pragma unroll
    for (int bj = 0; bj < 2; ++bj)
#pragma unroll
      for (int n = 0; n < 2; ++n) g4[bj][n] = *(const f32x4*)(gam + 32 * bj + 8 * fq + 4 * n);
#pragma unroll
    for (int ai = 0; ai < 2; ++ai)
#pragma unroll
      for (int m = 0; m < 4; ++m) {
        const int t = u.pm * BM + ai * HALF + wr * 64 + m * 16 + fr;
        int b, pos;
        if (rowbase == 0) { b = t >> 12; pos = t & 4095; } else { b = t >> 8; pos = 4096 + (t & 255); }
        u16* base = qkv + (size_t)(b * 32 + chunk) * LTOT * 64;
        if (isV) {
#pragma unroll
          for (int bj = 0; bj < 2; ++bj)
#pragma unroll
            for (int n = 0; n < 2; ++n)
#pragma unroll
              for (int e = 0; e < 4; ++e) {
                int d = 32 * bj + 8 * fq + 4 * n + e;
                base[(size_t)d * LTOT + pos] = f2bf(acc[ai][bj][m][n][e]);
              }
        } else {
          float ss = 0.f;
#pragma unroll
          for (int bj = 0; bj < 2; ++bj)
#pragma unroll
            for (int n = 0; n < 2; ++n)
#pragma unroll
              for (int e = 0; e < 4; ++e) ss += acc[ai][bj][m][n][e] * acc[ai][bj][m][n][e];
          ss += __shfl_xor(ss, 16);
          ss += __shfl_xor(ss, 32);
          const float rinv = rsqrtf(ss * (1.f / 64.f) + EPSV);
          float o1[8], o2[8];
#pragma unroll
          for (int n = 0; n < 2; ++n) {
            f32x4 cs0 = (f32x4){1.f, 0.f, 1.f, 0.f}, cs1 = cs0;
            if (ropeT) { const float* rp = rope + (size_t)pos * 64 + 2 * (8 * fq + 4 * n); cs0 = *(const f32x4*)rp; cs1 = *(const f32x4*)(rp + 4); }
#pragma unroll
            for (int e = 0; e < 4; ++e) {
              float x1 = acc[ai][0][m][n][e] * (rinv * qs) * g4[0][n][e];
              float x2 = acc[ai][1][m][n][e] * (rinv * qs) * g4[1][n][e];
              float c = (e < 2) ? cs0[2 * e] : cs1[2 * (e - 2)], s = (e < 2) ? cs0[2 * e + 1] : cs1[2 * (e - 2) + 1];
              o1[n * 4 + e] = x1 * c - x2 * s;
              o2[n * 4 + e] = x2 * c + x1 * s;
            }
          }
          u16* dst = base + (size_t)pos * 64 + 8 * fq;
          *(uint4*)(dst) = make_uint4(pack_bf16(o1[0], o1[1]), pack_bf16(o1[2], o1[3]), pack_bf16(o1[4], o1[5]), pack_bf16(o1[6], o1[7]));
          *(uint4*)(dst + 32) = make_uint4(pack_bf16(o2[0], o2[1]), pack_bf16(o2[2], o2[3]), pack_bf16(o2[4], o2[5]), pack_bf16(o2[6], o2[7]));
        }
      }
  }
};
}

constexpr int KROW = 144, VROW = 144;
constexpr int KT_B = 64 * KROW, VT_B = 64 * VROW, KV_B = KT_B + VT_B;
constexpr int RPB_OFF = 2 * KV_B;
constexpr int NAT_C = 384, NAT_B = 256, NAT_A = 384, NAT_LAT = NAT_C + NAT_B + NAT_A, NAT_CTX = 64;

DI void attn_item(const Params& p, int layer, int item, char* smem) {
  const int tid = tidx(), lane = tid & 63, wid = tid >> 6, l32 = lane & 31, h = lane >> 5;
  int mode, b, hh, qb;
  if (item < NAT_C) { mode = 0; b = item / 96; int rem = item % 96; hh = rem >> 4; qb = rem & 15; }
  else if (item < NAT_C + NAT_B) { int it = item - NAT_C; mode = 1; b = it >> 6; hh = (it & 63) >> 4; qb = it & 15; }
  else if (item < NAT_LAT) { int it = item - NAT_C - NAT_B; mode = 2; b = it / 96; int rem = it % 96; hh = rem >> 4; qb = rem & 15; }
  else { int it = item - NAT_LAT; mode = 3; b = it >> 4; hh = it & 15; qb = 0; }

  int qchunk, kchunk, vchunk, head16, t0 = 0, t1 = 0, qpos0 = qb * 256;
  bool hasSink = false; float sinkv = 0.f;
  int maskmode = 0;
  if (mode == 0) { qchunk = 22 + hh; kchunk = 28 + hh / 3; vchunk = 30 + hh / 3; head16 = 10 + hh; t0 = 0; t1 = 64; }
  else if (mode == 1) {
    qchunk = 10 + hh; kchunk = 14 + hh; vchunk = 18 + hh; head16 = 6 + hh; maskmode = 1;
    t0 = min(max(4 * qb - 4, 0), 56); t1 = min(max(4 * qb + 3 - 4, 0), 56) + 8;
  } else if (mode == 2) {
    qchunk = hh; kchunk = 6 + hh / 3; vchunk = 8 + hh / 3; head16 = hh; maskmode = 2;
    t0 = max(0, 4 * qb - 2); t1 = min(64, 4 * qb + 6); hasSink = true; sinkv = p.sink[layer * 6 + hh];
  } else {
    head16 = hh; qpos0 = 4096;
    if (hh < 6) { qchunk = hh; kchunk = 6 + hh / 3; vchunk = 8 + hh / 3; hasSink = true; sinkv = p.sink[layer * 6 + hh]; }
    else if (hh < 10) { int hb = hh - 6; qchunk = 10 + hb; kchunk = 14 + hb; vchunk = 18 + hb; }
    else { int hc = hh - 10; qchunk = 22 + hc; kchunk = 28 + hc / 3; vchunk = 30 + hc / 3; }
  }
  const int n_it = 4 + (t1 - t0);
  const u16* Qb = p.QKV + (size_t)(b * 32 + qchunk) * LTOT * 64;
  const u16* Kb = p.QKV + (size_t)(b * 32 + kchunk) * LTOT * 64;
  const u16* Vb = p.QKV + (size_t)(b * 32 + vchunk) * LTOT * 64;
  float* s_rpb = (float*)(smem + RPB_OFF);
  if (mode == 1) {
    const float* rp = p.rpb + (size_t)(layer * 4 + hh) * 465;
    for (int e = tid; e < 465; e += NTHR) s_rpb[e] = rp[e] * LOG2E;
  }

  const int qpos = qpos0 + wid * 32 + l32;
  bf16x8 qf[4];
#pragma unroll
  for (int s = 0; s < 4; ++s) qf[s] = *(const bf16x8*)(Qb + (size_t)qpos * 64 + s * 16 + h * 8);

  f32x16 o0, o1;
#pragma unroll
  for (int r = 0; r < 16; ++r) { o0[r] = 0.f; o1[r] = 0.f; }
  const int btype = (mode == 3) ? (hh < 6 ? 0 : (hh < 10 ? 1 : 2)) : (mode == 0 ? 2 : (mode == 1 ? 1 : 0));
  float m_fix = p.bounds[layer * 8 + btype];
  if (mode == 1) m_fix += p.bounds[layer * 8 + 4 + hh];
  f32x16 cinit, lacc;
#pragma unroll
  for (int r = 0; r < 16; ++r) { cinit[r] = -m_fix; lacc[r] = 0.f; }
  const bf16x8 ones = {(short)0x3F80, (short)0x3F80, (short)0x3F80, (short)0x3F80, (short)0x3F80, (short)0x3F80, (short)0x3F80, (short)0x3F80};

  const int lr = tid >> 3, lc = tid & 7;
  uint4 ka0, va0, kb0, vb0;
#define TILE_OF(it) ((it) < 4 ? 64 + (it) : t0 + (it) - 4)
#define AGLOAD(K0, V0, tile)                                                           \
  {                                                                                    \
    K0 = *(const uint4*)(Kb + (size_t)((tile) * 64 + lr) * 64 + lc * 8);               \
    V0 = *(const uint4*)(Vb + (size_t)(lr) * LTOT + (tile) * 64 + lc * 8);             \
  }
#define ASWRITE(K0, V0, buf)                                                           \
  {                                                                                    \
    *(uint4*)(smem + (buf) * KV_B + (lr) * KROW + lc * 16) = K0;                       \
      \
                       \
    char* vd = smem + (buf) * KV_B + KT_B + (lr) * VROW + (16 * (lc >> 1) + 4 * (lc & 1)) * 2; \
    *(uint2*)(vd) = make_uint2(V0.x, V0.y);                                            \
    *(uint2*)(vd + 16) = make_uint2(V0.z, V0.w);                                       \
  }

  const int tq = qb * 256 + wid * 32 + l32;
  auto compute = [&](const int bufsel, const int tile) {
    bool skip = false;
    if (tile < 64) {
      if (maskmode == 1) {
        int qr = (qb * 256 + wid * 32) >> 6;
        int krw = min(max(qr - 4, 0), 56);
        skip = (tile < krw) || (tile >= krw + 8);
      } else if (maskmode == 2) {
        int q0w = qb * 256 + wid * 32, tk0 = tile * 64;
        skip = (tk0 > q0w + 31 + 128) || (tk0 + 63 < q0w - 128);
      }
    }
    if (!skip) {
      const char* sK = smem + bufsel * KV_B;
      const char* sV = sK + KT_B;
      f32x16 S[2];
      __builtin_amdgcn_s_setprio(1);
#pragma unroll
      for (int kt = 0; kt < 2; ++kt) {
#pragma unroll
        for (int s = 0; s < 4; ++s) {
          bf16x8 kf = *(const bf16x8*)(sK + (kt * 32 + l32) * KROW + s * 32 + h * 16);
          S[kt] = MFMA32(kf, qf[s], s == 0 ? cinit : S[kt]);
        }
      }
      __builtin_amdgcn_s_setprio(0);
      if (tile < 64 && maskmode == 1) {
        int qr = tq >> 6, qc = tq & 63;
        int ws = min(max(qc - 8, 0), 48);
        int dr = tile - qr + 7;
#pragma unroll
        for (int kt = 0; kt < 2; ++kt)
#pragma unroll
          for (int r = 0; r < 16; ++r) {
            int kc = kt * 32 + crow(r, h);
            bool ok = (unsigned)(kc - ws) < 16u;
            int bi = ok ? (dr * 31 + kc - qc + 15) : 0;
            float bv = s_rpb[bi];
            S[kt][r] = ok ? (S[kt][r] + bv) : -INFINITY;
          }
      } else if (tile < 64 && maskmode == 2) {
#pragma unroll
        for (int kt = 0; kt < 2; ++kt)
#pragma unroll
          for (int r = 0; r < 16; ++r) {
            int tk = tile * 64 + kt * 32 + crow(r, h);
            int dd = tq - tk;
            bool ok = (dd <= 128) && (dd >= -128);
            S[kt][r] = ok ? S[kt][r] : -INFINITY;
          }
      }
#pragma unroll
      for (int r = 0; r < 16; ++r) {
        S[0][r] = __builtin_amdgcn_exp2f(S[0][r]);
        S[1][r] = __builtin_amdgcn_exp2f(S[1][r]);
      }
#pragma unroll
      for (int kt = 0; kt < 2; ++kt)
#pragma unroll
        for (int s2 = 0; s2 < 2; ++s2) {
          uint4 pw;
          pw.x = pack_bf16(S[kt][8 * s2 + 0], S[kt][8 * s2 + 1]);
          pw.y = pack_bf16(S[kt][8 * s2 + 2], S[kt][8 * s2 + 3]);
          pw.z = pack_bf16(S[kt][8 * s2 + 4], S[kt][8 * s2 + 5]);
          pw.w = pack_bf16(S[kt][8 * s2 + 6], S[kt][8 * s2 + 7]);
          bf16x8 pf = __builtin_bit_cast(bf16x8, pw);
          const int koff = (kt * 32 + 16 * s2 + 8 * h) * 2;
          {
            bf16x8 vf = *(const bf16x8*)(sV + l32 * VROW + koff);
            o0 = MFMA32(vf, pf, o0);
            lacc = MFMA32(ones, pf, lacc);
          }
          {
            bf16x8 vf = *(const bf16x8*)(sV + (32 + l32) * VROW + koff);
            o1 = MFMA32(vf, pf, o1);
          }
        }
    }
  };

  AGLOAD(ka0, va0, TILE_OF(0));
  if (n_it > 1) { AGLOAD(kb0, vb0, TILE_OF(1)); }
  ASWRITE(ka0, va0, 0);
  if (n_it > 2) { AGLOAD(ka0, va0, TILE_OF(2)); }
  __syncthreads();
  for (int it = 0; it < n_it; it += 2) {
    if (it + 1 < n_it) { ASWRITE(kb0, vb0, 1); }
    if (it + 3 < n_it) { AGLOAD(kb0, vb0, TILE_OF(it + 3)); }
    __builtin_amdgcn_sched_barrier(0);
    compute(0, TILE_OF(it));
    __syncthreads();
    if (it + 1 < n_it) {
      if (it + 2 < n_it) { ASWRITE(ka0, va0, 0); }
      if (it + 4 < n_it) { AGLOAD(ka0, va0, TILE_OF(it + 4)); }
      __builtin_amdgcn_sched_barrier(0);
      compute(1, TILE_OF(it + 1));
      __syncthreads();
    }
  }
#undef AGLOAD
#undef ASWRITE
#undef TILE_OF

  float l_tot = lacc[0];
  if (hasSink) l_tot += __builtin_amdgcn_exp2f(sinkv * LOG2E - m_fix);
  float inv = 1.f / l_tot;
  int T = (mode == 3) ? (TLAT + b * 256 + (qpos - 4096)) : (b * 4096 + qpos);
  u16* od = p.O + (size_t)T * LDK + head16 * 64;
#pragma unroll
  for (int g = 0; g < 4; ++g) {
    int d0 = 8 * g + 4 * h;
    *(uint2*)(od + d0) = make_uint2(pack_bf16(o0[4 * g] * inv, o0[4 * g + 1] * inv), pack_bf16(o0[4 * g + 2] * inv, o0[4 * g + 3] * inv));
    *(uint2*)(od + 32 + d0) = make_uint2(pack_bf16(o1[4 * g] * inv, o1[4 * g + 1] * inv), pack_bf16(o1[4 * g + 2] * inv, o1[4 * g + 3] * inv));
  }
}

DI void run_gphase(const Params& p, int g, char* smem, int coff = 0) {
  using namespace pg8;
  LAS unsigned char* lds = (LAS unsigned char*)smem;
  const int layer = (g - 1) / 7, ph = (g - 1) % 7 + 1;
  const bool hasc = (g + 1 <= 23);
  const int cl = g / 7;
  const int bid = blockIdx.x, nb = gridDim.x;
  const float* xin_lat; const float* xin_ctx; float* xo_lat = p.out; float* xo_ctx = p.xctx;
  { const float* a_ = p.x; const float* c_ = p.ctx; asm volatile("" : "+s"(a_), "+s"(c_));
    float* b_ = p.out; float* d_ = p.xctx; asm volatile("" : "+s"(b_), "+s"(d_));
    xin_lat = (layer == 0) ? a_ : (const float*)b_; xin_ctx = (cl == 0) ? c_ : (const float*)d_; xo_lat = b_; xo_ctx = d_; }
  switch (ph) {
    case 1: {
      if (hasc) {
        OneUnit S; S.u.pm = bid & 3; S.u.pn = bid >> 2; S.valid = bid < 32;
        EpiQKV E; E.qkv = p.QKV; E.qkn = p.qk_norm + cl * 6 * 64; E.rope = p.rope; E.rowbase = TLAT;
        gemm_phase(lds, Gemm{p.H + (size_t)TLAT * LDK, p.wt_in + (size_t)cl * INW * LDK, DM}, S, E);
      }
      norm_dyn(p, layer, 0, 0, TLAT, &p.counters[32 + g + coff]);
    } break;
    case 2: {
      TileOrder S; S.init(64, 8, nb, bid, 0);
      EpiQKV E; E.qkv = p.QKV; E.qkn = p.qk_norm + layer * 6 * 64; E.rope = p.rope; E.rowbase = 0;
      gemm_phase(lds, Gemm{p.H, p.wt_in + (size_t)layer * INW * LDK, DM}, S, E);
      if (hasc)
        for (int i = bid; i < NAT_CTX; i += nb) attn_item(p, cl, NAT_LAT + i, smem);
    } break;
    case 3: {
      const int nctx = hasc ? 16 : 0;
      for (int it = grab(&p.counters[g + coff]); it < NAT_LAT + nctx; it = grab(&p.counters[g + coff])) {
        if (it < NAT_C) attn_item(p, layer, it, smem);
        else if (it < NAT_C + nctx) {
          int j = it - NAT_C;
          OneUnit S; S.u.pm = j & 3; S.u.pn = j >> 2; S.valid = true;
          EpiRes E; E.src = xin_ctx; E.dst = xo_ctx; E.gate = p.mod + ((size_t)cl * 5 + 4) * 6144 + 2 * 1024;
          gemm_phase(lds, Gemm{p.O + (size_t)TLAT * LDK, p.wt_out + (size_t)cl * DM * LDK, DM}, S, E);
        } else attn_item(p, layer, it - nctx, smem);
      }
    } break;
    case 4: {
      TileOrder S; S.init(64, 4, nb, bid, 0);
      Unit u0;
      for (int i = 0; S.next(i, u0); ++i) {
        OneUnit S1; S1.u = u0; S1.valid = true;
        EpiRes E; E.src = xin_lat; E.dst = xo_lat; E.gate = p.mod + ((size_t)layer * 5 + (u0.pm >> 4)) * 6144 + 2 * 1024;
        gemm_phase(lds, Gemm{p.O, p.wt_out + (size_t)layer * DM * LDK, DM}, S1, E);
      }
      if (hasc) norm_static(p, cl, 1, TLAT, TTOT);
    } break;
    case 5: {
      if (hasc) {
        OneUnit S; S.u.pm = bid & 3; S.u.pn = bid >> 2; S.valid = bid < 88;
        EpiGU E; E.act = p.ACT + (size_t)TLAT * LDF;
        gemm_phase(lds, Gemm{p.H + (size_t)TLAT * LDK, p.wt_gu + (size_t)cl * GUW * LDK, DM}, S, E);
      }
      norm_dyn(p, layer, 1, 0, TLAT, &p.counters[32 + g + coff]);
    } break;
    case 6: {
      if (hasc) {
        int j = (nb == 256) ? bid - 240 : bid;
        OneUnit S; S.u.pm = j & 3; S.u.pn = (j >> 2) & 3; S.valid = (j >= 0 && j < 16);
        EpiRes E; E.src = xo_ctx; E.dst = xo_ctx; E.gate = p.mod + ((size_t)cl * 5 + 4) * 6144 + 5 * 1024;
        gemm_phase(lds, Gemm{p.ACT + (size_t)TLAT * LDF, p.wt_down + (size_t)cl * DM * LDF, FFN}, S, E);
      }
      TileOrder S; S.init(64, 22, nb, bid, (hasc && nb == 256) ? 1 : 0);
      EpiGU E; E.act = p.ACT;
      gemm_phase(lds, Gemm{p.H, p.wt_gu + (size_t)layer * GUW * LDK, DM}, S, E);
    } break;
    case 7: {
      TileOrder S; S.init(64, 4, nb, bid, 0);
      Unit u0;
      for (int i = 0; S.next(i, u0); ++i) {
        OneUnit S1; S1.u = u0; S1.valid = true;
        EpiRes E; E.src = xo_lat; E.dst = xo_lat; E.gate = p.mod + ((size_t)layer * 5 + (u0.pm >> 4)) * 6144 + 5 * 1024;
        gemm_phase(lds, Gemm{p.ACT, p.wt_down + (size_t)layer * DM * LDF, FFN}, S1, E);
      }
      if (hasc) norm_static(p, cl, 0, TLAT, TTOT);
    } break;
  }
}

#define XB_XCNT(j)  (256  + 64 * (j))
#define XB_XSUB(j)  (1280 + 64 * (j))
#define XB_XGEN(j)  (2304 + 64 * (j))
#define XB_TOP      3328
#define XB_TOPGEN   3392
#define XCD_BAR_WORDS 3456
#define LAS __attribute__((address_space(3)))
DI unsigned xb_ld(unsigned* p) { return __hip_atomic_load(p, __ATOMIC_RELAXED, __HIP_MEMORY_SCOPE_AGENT); }
DI unsigned xb_add(unsigned* p, unsigned v) { return __hip_atomic_fetch_add(p, v, __ATOMIC_RELAXED, __HIP_MEMORY_SCOPE_AGENT); }
DI unsigned xb_xcc_id() { return (unsigned)__builtin_amdgcn_s_getreg((3 << 11) | 20) & 0xFu; }
struct XcdBarrier { unsigned* bar; unsigned x; volatile LAS unsigned* st; };
DI XcdBarrier xcd_barrier_post(unsigned* bar, volatile LAS unsigned* st) {
  XcdBarrier b; b.bar = bar; b.x = xb_xcc_id(); b.st = st;
  if (threadIdx.x == 0) (void)xb_add(&bar[XB_XCNT(b.x)], 1u);
  return b;
}
DI void xcd_barrier_complete(unsigned* bar, unsigned x, unsigned& nloc, unsigned& nx) {
  const unsigned G = gridDim.x;
  unsigned sum, cnt, mine;
  for (;;) {
    sum = 0u; cnt = 0u; mine = 0u;
#pragma unroll
    for (unsigned j = 0; j < 16; ++j) { const unsigned c = xb_ld(&bar[XB_XCNT(j)]); sum += c; cnt += (c > 0u) ? 1u : 0u; mine = (j == x) ? c : mine; }
    if (sum == G) break;
    __builtin_amdgcn_s_sleep(1);
  }
  nloc = mine > 0u ? mine : 1u; nx = cnt > 0u ? cnt : 1u;
}
DI void xcd_barrier(const XcdBarrier& b) {
  asm volatile("s_waitcnt vmcnt(0)" ::: "memory");
  __syncthreads();
  if (threadIdx.x == 0) {
    unsigned* bar = b.bar;
    unsigned bx = b.x;
    asm volatile("" : "+s"(bx));
    __builtin_amdgcn_s_waitcnt(0);
    unsigned nloc = b.st[0], nx = b.st[1];
    if (nloc == 0u) { xcd_barrier_complete(bar, bx, nloc, nx); b.st[0] = nloc; b.st[1] = nx; }
    const unsigned old = xb_add(&bar[XB_XSUB(bx)], 1u);
    const unsigned gen = old / nloc;
    if (old + 1u == (gen + 1u) * nloc) {
      __builtin_amdgcn_fence(__ATOMIC_RELEASE, "agent");
      asm volatile("s_waitcnt vmcnt(0)" ::: "memory");
      const unsigned og = xb_add(&bar[XB_TOP], 1u);
      const unsigned tg = og / nx;
      if (og + 1u == (tg + 1u) * nx) xb_add(&bar[XB_TOPGEN], 1u);
      else { while (xb_ld(&bar[XB_TOPGEN]) == tg) __builtin_amdgcn_s_sleep(1); }
      __builtin_amdgcn_fence(__ATOMIC_ACQUIRE, "agent");
      xb_add(&bar[XB_XGEN(bx)], 1u);
      asm volatile("s_waitcnt vmcnt(0)" ::: "memory");
    } else {
      while (xb_ld(&bar[XB_XGEN(bx)]) == gen) __builtin_amdgcn_s_sleep(1);
      __builtin_amdgcn_fence(__ATOMIC_ACQUIRE, "agent");
      asm volatile("s_waitcnt vmcnt(0)" ::: "memory");
    }
  }
  __syncthreads();
}


__global__ void __launch_bounds__(512, 2) fwd_megakernel(Params p) {
  extern __shared__ __attribute__((aligned(16))) unsigned char dsm[];
  char* smem = (char*)dsm;
  cg::grid_group grid = cg::this_grid();
  if (threadIdx.x == 0) *(uint4*)(dsm + 131072) = make_uint4(0u, 0u, 0u, 0u);
  __syncthreads();
  XcdBarrier xb = xcd_barrier_post(p.counters + 1024, (volatile LAS unsigned*)(dsm + 131072));
  phase0(p, smem);
  grid.sync();
  norm_static(p, 0, 0, TLAT, TTOT);
  xcd_barrier(xb);
  for (int g = 1; g <= 7 * NLAYER; ++g) {
    run_gphase(p, g, smem);
#ifdef PROBE_DOUBLE
    if ((g - 1) % 7 + 1 == PROBE_DOUBLE) { xcd_barrier(xb); run_gphase(p, g, smem, 100); }
#endif
    if (g < 7 * NLAYER) xcd_barrier(xb);
  }
}

extern "C" void kernel_launch(void* const* d_in, const int* in_sizes, int n_in, void* d_out, int out_size, void* d_ws,
                              size_t ws_size, hipStream_t stream) {
  Params p{};
  p.x = (const float*)d_in[0]; p.c = (const float*)d_in[1]; p.ctx = (const float*)d_in[2]; p.c_ctx = (const float*)d_in[3];
  p.w_mod = (const float*)d_in[4]; p.b_mod = (const float*)d_in[5]; p.norm_attn = (const float*)d_in[6];
  p.norm_ffn = (const float*)d_in[7]; p.w_in = (const float*)d_in[8]; p.qk_norm = (const float*)d_in[9];
  p.sink = (const float*)d_in[10]; p.rpb = (const float*)d_in[11]; p.w_out = (const float*)d_in[12];
  p.w_gate = (const float*)d_in[13]; p.w_up = (const float*)d_in[14]; p.w_down = (const float*)d_in[15];
  p.out = (float*)d_out;
  char* w = (char*)d_ws;
  size_t off = 0;
  auto take = [&](size_t bytes) { char* r = w + off; off += (bytes + 255) & ~(size_t)255; return r; };
  p.counters = (unsigned*)take(4096 + XCD_BAR_WORDS * 4);
  p.wt_in = (u16*)take((size_t)NLAYER * INW * LDK * 2);
  p.wt_out = (u16*)take((size_t)NLAYER * DM * LDK * 2);
  p.wt_gu = (u16*)take((size_t)NLAYER * GUW * LDK * 2);
  p.wt_down = (u16*)take((size_t)NLAYER * DM * LDF * 2);
  p.H = (u16*)take((size_t)TTOT * LDK * 2);
  p.mod = (float*)take((size_t)NLAYER * 5 * 6144 * 4);
  p.xctx = (float*)take((size_t)TCTX * DM * 4);
  p.rope = (float*)take((size_t)SEQL * 32 * 2 * 4);
  p.bounds = (float*)take(256);
  p.QKV = (u16*)take((size_t)NBATCH * 32 * LTOT * 64 * 2);
  p.O = (u16*)take((size_t)TTOT * LDK * 2);
  p.ACT = p.QKV;

  hipMemsetAsync(p.counters, 0, 4096 + XCD_BAR_WORDS * 4, stream);

  static int grid_blocks = 0;
  if (!grid_blocks) {
    int dev = 0, cus = 0, per_cu = 0;
    hipGetDevice(&dev);
    hipDeviceGetAttribute(&cus, hipDeviceAttributeMultiprocessorCount, dev);
    hipFuncSetAttribute((const void*)fwd_megakernel, hipFuncAttributeMaxDynamicSharedMemorySize, DYN_LDS);
    hipOccupancyMaxActiveBlocksPerMultiprocessor(&per_cu, fwd_megakernel, NTHR, DYN_LDS);
    if (per_cu > 1) per_cu = 1;
    if (per_cu < 1) per_cu = 1;
    grid_blocks = cus * per_cu;
  }
  void* args[] = {&p};
  hipError_t e = hipLaunchCooperativeKernel((void*)fwd_megakernel, dim3(grid_blocks), dim3(NTHR), args, DYN_LDS, stream);
  if (e != hipSuccess) fprintf(stderr, "cooperative launch failed: %s (grid %d)\n", hipGetErrorString(e), grid_blocks);
}
```

```cpp
#include <hip/hip_runtime.h>
#include <hip/hip_cooperative_groups.h>
#include <cstdio>
namespace cg = cooperative_groups;

typedef unsigned short u16;
typedef __attribute__((ext_vector_type(8))) short bf16x8;
typedef __attribute__((ext_vector_type(16))) float f32x16;
typedef __attribute__((ext_vector_type(4))) float f32x4;
typedef __attribute__((ext_vector_type(2))) float f32x2;
typedef __attribute__((ext_vector_type(2))) __bf16 bf16x2_t;
#define DI __device__ __forceinline__
#define LAS __attribute__((address_space(3)))
#define MFMA32(a, b, c) __builtin_amdgcn_mfma_f32_32x32x16_bf16((a), (b), (c), 0, 0, 0)

constexpr int DM = 1024, NBATCH = 4, SEQL = 4096, CTXL = 256, LTOT = 4352;
constexpr int TLAT = NBATCH * SEQL, TCTX = NBATCH * CTXL, TTOT = TLAT + TCTX;
constexpr int NLAYER = 4, INW = 2048, FFN = 2816, GUW = 2 * FFN;
constexpr int LDK = DM, LDF = FFN;
constexpr int NTHR = 512;
constexpr int DYN_LDS = 131072 + 64;
constexpr float EPSV = 1e-6f;
constexpr float LOG2E = 1.4426950408889634f;

struct Params {
  const float *x, *c, *ctx, *c_ctx, *w_mod, *b_mod, *norm_attn, *norm_ffn, *w_in, *qk_norm, *sink, *rpb,
              *w_out, *w_gate, *w_up, *w_down;
  float* out;
  u16 *wt_in, *wt_out, *wt_gu, *wt_down, *H, *QKV, *O, *ACT;
  float *mod, *xctx, *rope, *bounds;
  unsigned* counters;
};

DI unsigned pack_bf16(float a, float b) {
  f32x2 v = {a, b};
  bf16x2_t r = __builtin_convertvector(v, bf16x2_t);
  return __builtin_bit_cast(unsigned, r);
}
DI u16 f2bf(float a) { return (u16)(pack_bf16(a, 0.f) & 0xffffu); }
DI int tidx() { int t = threadIdx.x; asm volatile("" : "+v"(t)); return t; }
DI int crow(int r, int h) { return (r & 3) + 8 * (r >> 2) + 4 * h; }

DI int grab(unsigned* ctr) {
  __shared__ int s_grab;
  if (threadIdx.x == 0) s_grab = (int)atomicAdd(ctr, 1u);
  __syncthreads();
  int v = s_grab;
  __syncthreads();
  return v;
}

DI void phase0(const Params& p, char* smem) {
  const int tid = tidx();
  constexpr int NWP = NLAYER * 2880 / 2, NMOD = NLAYER * 96, NROPE = 256, NBND = 1;
  const float* w_in_ = p.w_in; const float* w_out_ = p.w_out; const float* w_gate_ = p.w_gate;
  const float* w_up_ = p.w_up; const float* w_down_ = p.w_down;
  asm volatile("" : "+v"(w_in_), "+v"(w_out_), "+v"(w_gate_), "+v"(w_up_), "+v"(w_down_));
  {
    const int half = tid >> 8, t = tid & 255;
    float* tile = (float*)(smem + half * 16640);
    const float* src; int N, k0, n0, Kd, up, kind; u16* dst;
    const float* nsrc = nullptr; int nN = 0, nk0 = 0, nn0 = 0, nKd = 0, nup = 0, nkind = 0; u16* ndst = nullptr;
    float4 cur[4], nxt[4];
#define WDECODE(item_, src_, N_, k0_, n0_, Kd_, up_, kind_, dst_)                                                              \
    {                                                                                                                          \
      const int it2_ = (item_) * 2 + half; const int layer_ = it2_ / 2880; int idx_ = it2_ % 2880; up_ = 0;                    \
      if (idx_ < 512) { kind_ = 0; k0_ = (idx_ >> 5) * 64; n0_ = (idx_ & 31) * 64; src_ = w_in_ + (size_t)layer_ * DM * INW; N_ = INW; dst_ = p.wt_in + (size_t)layer_ * INW * DM; Kd_ = DM; } \
      else if (idx_ < 768) { idx_ -= 512; kind_ = 0; k0_ = (idx_ >> 4) * 64; n0_ = (idx_ & 15) * 64; src_ = w_out_ + (size_t)layer_ * DM * DM; N_ = DM; dst_ = p.wt_out + (size_t)layer_ * DM * DM; Kd_ = DM; } \
      else if (idx_ < 2176) { idx_ -= 768; up_ = idx_ >= 704; if (up_) idx_ -= 704; kind_ = 1; k0_ = (idx_ / 44) * 64; n0_ = (idx_ % 44) * 64; \
        src_ = (up_ ? w_up_ : w_gate_) + (size_t)layer_ * DM * FFN; N_ = FFN; dst_ = p.wt_gu + (size_t)layer_ * GUW * DM; Kd_ = DM; } \
      else { idx_ -= 2176; kind_ = 0; k0_ = (idx_ >> 4) * 64; n0_ = (idx_ & 15) * 64; src_ = w_down_ + (size_t)layer_ * FFN * DM; N_ = DM; dst_ = p.wt_down + (size_t)layer_ * DM * FFN; Kd_ = FFN; } \
    }
#define WLOAD(v_, src_, N_, k0_, n0_)                                                                                          \
    _Pragma("unroll") for (int ps = 0; ps < 4; ++ps) {                                                                         \
      int kk = (t >> 4) + 16 * ps, nn = (t & 15) * 4;                                                                          \
      v_[ps] = *(const float4*)(src_ + (size_t)(k0_ + kk) * N_ + n0_ + nn);                                                    \
    }
    int item = blockIdx.x;
    if (item < NWP) { WDECODE(item, src, N, k0, n0, Kd, up, kind, dst); WLOAD(cur, src, N, k0, n0); }
    for (; item < NWP; item += gridDim.x) {
      const int nitem = item + gridDim.x;
      if (nitem < NWP) { WDECODE(nitem, nsrc, nN, nk0, nn0, nKd, nup, nkind, ndst); WLOAD(nxt, nsrc, nN, nk0, nn0); }
#pragma unroll
      for (int ps = 0; ps < 4; ++ps) {
        int kk = (t >> 4) + 16 * ps, nn = (t & 15) * 4;
        tile[kk * 65 + nn] = cur[ps].x; tile[kk * 65 + nn + 1] = cur[ps].y; tile[kk * 65 + nn + 2] = cur[ps].z; tile[kk * 65 + nn + 3] = cur[ps].w;
      }
      __syncthreads();
      {
        int n = t >> 2, kc = (t & 3) * 16;
        unsigned w[8];
#pragma unroll
        for (int j = 0; j < 8; ++j) w[j] = pack_bf16(tile[(kc + 2 * j) * 65 + n], tile[(kc + 2 * j + 1) * 65 + n]);
        int col = n0 + n;
        int row = kind ? ((col >> 7) * 256 + up * 128 + (col & 127)) : col;
        uint4* d = (uint4*)(dst + (size_t)row * Kd + k0 + kc);
        d[0] = make_uint4(w[0], w[1], w[2], w[3]);
        d[1] = make_uint4(w[4], w[5], w[6], w[7]);
      }
      __syncthreads();
#pragma unroll
      for (int ps = 0; ps < 4; ++ps) cur[ps] = nxt[ps];
      src = nsrc; N = nN; k0 = nk0; n0 = nn0; Kd = nKd; up = nup; kind = nkind; dst = ndst;
    }
#undef WDECODE
#undef WLOAD
  }
  for (int item = NWP + blockIdx.x; item < NWP + NMOD + NROPE + NBND; item += gridDim.x) {
    if (false) {
    } else if (item < NWP + NMOD) {
      int it = item - NWP, layer = it / 96, cg0 = (it % 96) * 64;
      float* sc = (float*)smem;
      float* red = sc + 5 * 1024;
      for (int e = tid; e < 5 * 1024; e += NTHR) {
        int mb = e >> 10, k = e & 1023;
        float v = (mb < 4) ? p.c[mb * 1024 + k] : p.c_ctx[k];
        sc[e] = v / (1.f + __expf(-v));
      }
      __syncthreads();
      int col = cg0 + (tid & 63), kq = tid >> 6;
      const float* w = p.w_mod + (size_t)layer * DM * 6144 + col;
      float a0 = 0, a1 = 0, a2 = 0, a3 = 0, a4 = 0;
#pragma unroll 32
      for (int k = kq * 128; k < kq * 128 + 128; ++k) {
        float wv = w[(size_t)k * 6144];
        a0 += sc[k] * wv; a1 += sc[1024 + k] * wv; a2 += sc[2048 + k] * wv; a3 += sc[3072 + k] * wv; a4 += sc[4096 + k] * wv;
      }
      int c64 = tid & 63;
      red[(kq * 5 + 0) * 64 + c64] = a0; red[(kq * 5 + 1) * 64 + c64] = a1; red[(kq * 5 + 2) * 64 + c64] = a2;
      red[(kq * 5 + 3) * 64 + c64] = a3; red[(kq * 5 + 4) * 64 + c64] = a4;
      __syncthreads();
      for (int e = tid; e < 5 * 64; e += NTHR) {
        int mb = e >> 6, cc = e & 63;
        float s = 0.f;
#pragma unroll
        for (int q = 0; q < 8; ++q) s += red[(q * 5 + mb) * 64 + cc];
        p.mod[((size_t)layer * 5 + mb) * 6144 + cg0 + cc] = s + p.b_mod[layer * 6144 + cg0 + cc];
      }
      __syncthreads();
    } else if (item >= NWP + NMOD + NROPE) {
      unsigned* mx = (unsigned*)smem;
      for (int e = tid; e < NLAYER * 10; e += NTHR) mx[e] = 0u;
      __syncthreads();
      for (int e = tid; e < NLAYER * 6 * 64; e += NTHR) atomicMax(&mx[(e / 384) * 10 + (e % 384) / 64], __float_as_uint(fabsf(p.qk_norm[e])));
      for (int e = tid; e < NLAYER * 4 * 465; e += NTHR) atomicMax(&mx[(e / 1860) * 10 + 6 + (e % 1860) / 465], __float_as_uint(fabsf(p.rpb[e])));
      __syncthreads();
      if (tid < NLAYER * 8) {
        int l = tid >> 3, j = tid & 7; float v = 0.f;
        if (j < 3) v = 0.125f * LOG2E * 64.f * 1.02f * __uint_as_float(mx[l * 10 + 2 * j]) * __uint_as_float(mx[l * 10 + 2 * j + 1]);
        else if (j >= 4) v = LOG2E * __uint_as_float(mx[l * 10 + 6 + (j - 4)]);
        p.bounds[tid] = v;
      }
      __syncthreads();
    } else {
      int e = (item - NWP - NMOD) * NTHR + tid;
      int t = e >> 5, pi = e & 31;
      float pos = (pi < 16) ? (float)(t >> 6) : (float)(t & 63);
      float inv = exp2f(-(float)(pi & 15) * (13.287712379549449f / 16.0f));
      float ang = pos * inv;
      p.rope[2 * e] = __cosf(ang);
      p.rope[2 * e + 1] = __sinf(ang);
    }
  }
}

DI const float* xrow_src(const Params& p, int layer, int t) {
  const float* a = p.x; const float* b = p.out; const float* c = p.ctx; const float* d = p.xctx;
  asm volatile("" : "+v"(a), "+v"(b), "+v"(c), "+v"(d));
  if (t < TLAT) return (layer == 0 ? a : b) + (size_t)t * DM;
  return (layer == 0 ? c : d) + (size_t)(t - TLAT) * DM;
}
DI float* xrow_dst(const Params& p, int t) {
  float* b = p.out; float* d = p.xctx;
  asm volatile("" : "+v"(b), "+v"(d));
  if (t < TLAT) return b + (size_t)t * DM;
  return d + (size_t)(t - TLAT) * DM;
}
DI int mb_of(int t) { return t < TLAT ? (t >> 12) : 4; }

DI void norm_row(const Params& p, int layer, int which, int t, int lane) {
  const float* g = (which ? p.norm_ffn : p.norm_attn) + layer * DM;
  const float* xr = which ? (const float*)xrow_dst(p, t) : xrow_src(p, layer, t);
  const float* md = p.mod + ((size_t)layer * 5 + mb_of(t)) * 6144 + (which ? 3 * 1024 : 0);
  float4 v[4];
  float ss = 0.f;
#pragma unroll
  for (int j = 0; j < 4; ++j) {
    v[j] = *(const float4*)(xr + lane * 4 + 256 * j);
    ss += v[j].x * v[j].x + v[j].y * v[j].y + v[j].z * v[j].z + v[j].w * v[j].w;
  }
#pragma unroll
  for (int o = 32; o >= 1; o >>= 1) ss += __shfl_xor(ss, o);
  float r = rsqrtf(ss * (1.f / 1024.f) + EPSV);
#pragma unroll
  for (int j = 0; j < 4; ++j) {
    int col = lane * 4 + 256 * j;
    float4 gg = *(const float4*)(g + col);
    float4 sh = *(const float4*)(md + col);
    float4 sc = *(const float4*)(md + 1024 + col);
    float o0 = v[j].x * r * gg.x * (1.f + sc.x) + sh.x;
    float o1 = v[j].y * r * gg.y * (1.f + sc.y) + sh.y;
    float o2 = v[j].z * r * gg.z * (1.f + sc.z) + sh.z;
    float o3 = v[j].w * r * gg.w * (1.f + sc.w) + sh.w;
    *(uint2*)(p.H + (size_t)t * LDK + col) = make_uint2(pack_bf16(o0, o1), pack_bf16(o2, o3));
  }
}
template <int R>
DI void norm_rows(const Params& p, int layer, int which, int t0, int tstep, int lane) {
  const float* g = (which ? p.norm_ffn : p.norm_attn) + layer * DM;
  const float* md = p.mod + ((size_t)layer * 5 + mb_of(t0)) * 6144 + (which ? 3 * 1024 : 0);
  float4 v[R][4];
  float ss[R];
#pragma unroll
  for (int r = 0; r < R; ++r) {
    const float* xr = which ? (const float*)xrow_dst(p, t0 + r * tstep) : xrow_src(p, layer, t0 + r * tstep);
#pragma unroll
    for (int j = 0; j < 4; ++j) v[r][j] = *(const float4*)(xr + lane * 4 + 256 * j);
  }
#pragma unroll
  for (int r = 0; r < R; ++r) {
    ss[r] = 0.f;
#pragma unroll
    for (int j = 0; j < 4; ++j) ss[r] += v[r][j].x * v[r][j].x + v[r][j].y * v[r][j].y + v[r][j].z * v[r][j].z + v[r][j].w * v[r][j].w;
  }
#pragma unroll
  for (int o = 32; o >= 1; o >>= 1)
#pragma unroll
    for (int r = 0; r < R; ++r) ss[r] += __shfl_xor(ss[r], o);
#pragma unroll
  for (int r = 0; r < R; ++r) ss[r] = rsqrtf(ss[r] * (1.f / 1024.f) + EPSV);
#pragma unroll
  for (int j = 0; j < 4; ++j) {
    int col = lane * 4 + 256 * j;
    float4 gg = *(const float4*)(g + col);
    float4 sh = *(const float4*)(md + col);
    float4 sc = *(const float4*)(md + 1024 + col);
    float m0 = gg.x * (1.f + sc.x), m1 = gg.y * (1.f + sc.y), m2 = gg.z * (1.f + sc.z), m3 = gg.w * (1.f + sc.w);
#pragma unroll
    for (int r = 0; r < R; ++r)
      *(uint2*)(p.H + (size_t)(t0 + r * tstep) * LDK + col) =
          make_uint2(pack_bf16(v[r][j].x * ss[r] * m0 + sh.x, v[r][j].y * ss[r] * m1 + sh.y), pack_bf16(v[r][j].z * ss[r] * m2 + sh.z, v[r][j].w * ss[r] * m3 + sh.w));
  }
}
DI void norm_static(const Params& p, int layer, int which, int row0, int row1) {
  const int tid = tidx(), lane = tid & 63, wid = tid >> 6;
  for (int t = row0 + blockIdx.x * 8 + wid; t < row1; t += gridDim.x * 8) norm_row(p, layer, which, t, lane);
}
DI void norm_dyn(const Params& p, int layer, int which, int row0, int row1, unsigned* ctr) {
  const int tid = tidx(), lane = tid & 63, wid = tid >> 6;
  const int nchunk = (row1 - row0) >> 5;
  while (true) {
    int ch = grab(ctr);
    if (ch >= nchunk) break;
    norm_rows<4>(p, layer, which, row0 + ch * 32 + wid, 8, lane);
  }
}

namespace pg8 {
typedef unsigned short bf16_t;
constexpr int BM = 256, BK = 64, HALF = 128, HTB = HALF * BK * 2, STAGE_BYTES = 8 * HTB, NXCD = 8, WGM = 8;
DI int lds_byte(int r, int c) { const int st = (r >> 4) * 2 + (c >> 5), rr = r & 15, cc = c & 31, ob = rr * 64 + cc * 2; return st * 1024 + (ob ^ (((ob >> 9) & 1) << 5)); }
DI void stage_rc(int b, int& R, int& C) { const int st = b / 1024, sb = b % 1024, swz = sb ^ (((sb >> 9) & 1) << 5); R = (st >> 1) * 16 + swz / 64; C = (st & 1) * 32 + (swz % 64) / 2; }
DI int perm32(int rho) { const int n = rho >> 4, i = rho & 15; return 8 * (i >> 2) + 4 * n + (i & 3); }
struct Unit { int pm, pn; };
struct Gemm { const bf16_t* A; const bf16_t* Bt; int K; };

struct TileOrder {
  int nM, nN, nwg, G, c, remap;
  DI void init(int nM_, int nN_, int G_, int c_, int remap_) { nM = nM_; nN = nN_; nwg = nM * nN; G = G_; c = c_; remap = remap_; }
  DI bool next(int i, Unit& u) const {
    long L = (long)i * G + c;
    if (remap) {
      if (c >= 240) { if (i >= 3) return false; }
      else if (c >= 128 && c < 144 && i == 5) L = 4L * G + (c + 112);
      else if (c >= 144 && c < 160 && i == 5) L = 3L * G + (c + 96);
    }
    if (L >= nwg) return false;
    int wgid = (int)L; { const int q = nwg / NXCD, r = nwg % NXCD, xcd = wgid % NXCD, off = wgid / NXCD; wgid = (xcd < r ? xcd * (q + 1) : r * (q + 1) + (xcd - r) * q) + off; }
    const int nig = WGM * nN, gid = wgid / nig, fm = gid * WGM, gsz = (nM - fm) < WGM ? (nM - fm) : WGM;
    u.pm = fm + ((wgid % nig) % gsz); u.pn = (wgid % nig) / gsz; return true;
  }
};
struct OneUnit {
  Unit u; bool valid;
  DI bool next(int i, Unit& o) const { if (i != 0 || !valid) return false; o = u; return true; }
};

template <class Epi, class Sched>
DI void gemm_phase(LAS unsigned char* lds, const Gemm g, const Sched& S, const Epi& E) {
  const int tid = tidx(), wid = __builtin_amdgcn_readfirstlane(tid >> 6), lane = tid & 63, wr = wid >> 2, wc = wid & 3, fr = lane & 15, fq = lane >> 4;
  int K = g.K; asm volatile("" : "+s"(K));
  const int nt = K / BK;
  unsigned voffA[2], voffB[2];
#pragma unroll
  for (int i = 0; i < 2; ++i) {
    int R, C; stage_rc(tid * 16 + i * 8192, R, C);
    int Rb = R;
    if (Epi::BMAP == 1) Rb = (R & ~31) + perm32(R & 31);
    if (Epi::BMAP == 2) Rb = 64 * (R >> 5) + perm32(R & 31);
    voffA[i] = (unsigned)(R * K + C) * 2u; voffB[i] = (unsigned)(Rb * K + C) * 2u;
  }
  const size_t kstep = (size_t)(BK * 2);
  const size_t hstep = (size_t)HALF * K * 2;
  const size_t hstepB = (Epi::BMAP == 2) ? (size_t)32 * K * 2 : hstep;
  const size_t tstep = 2 * hstep;
  const unsigned ldsw = (unsigned)wid * 1024u;
  const int aoff = lds_byte(wr * 64 + fr, fq * 8), boff = lds_byte(wc * 32 + fr, fq * 8);
#define PG8_SA(b, h) (((b) * 2 + (h)) * HTB)
#define PG8_SB(b, h) ((4 + (b) * 2 + (h)) * HTB)
#define PG8_STAGE(bufoff, gbase, voff) do { _Pragma("unroll") for (int _i = 0; _i < 2; ++_i) \
    __builtin_amdgcn_global_load_lds((const unsigned*)((const char*)(gbase) + (voff)[_i]), (LAS unsigned*)(lds + (bufoff) + ldsw + _i * 8192), 16, 0, 0); } while (0)
#define PG8_LDA(dst, b, h) do { _Pragma("unroll") for (int m = 0; m < 4; ++m) _Pragma("unroll") for (int k = 0; k < 2; ++k) dst[m][k] = *(const LAS bf16x8*)(lds + PG8_SA(b, h) + aoff + m * 2048 + k * 1024); } while (0)
#define PG8_LDB(dst, b, h) do { _Pragma("unroll") for (int n = 0; n < 2; ++n) _Pragma("unroll") for (int k = 0; k < 2; ++k) dst[n][k] = *(const LAS bf16x8*)(lds + PG8_SB(b, h) + boff + n * 2048 + k * 1024); } while (0)
#define PG8_MMA(ai, bj, At, Bt) do { __builtin_amdgcn_s_setprio(1); _Pragma("unroll") for (int m = 0; m < 4; ++m) _Pragma("unroll") for (int n = 0; n < 2; ++n) _Pragma("unroll") for (int k = 0; k < 2; ++k) \
    acc[ai][bj][m][n] = __builtin_amdgcn_mfma_f32_16x16x32_bf16(Bt[n][k], At[m][k], acc[ai][bj][m][n], 0, 0, 0); __builtin_amdgcn_s_setprio(0); } while (0)
#define PG8_WAIT_V(n) asm volatile("s_waitcnt vmcnt(" #n ")" ::: "memory")
#define PG8_WAIT_L(n) asm volatile("s_waitcnt lgkmcnt(" #n ")" ::: "memory")
#define PG8_BAR __builtin_amdgcn_s_barrier()
#define PG8_SCHED __builtin_amdgcn_sched_barrier(0)
  Unit cur, nxt; int ui = 0;
  if (!S.next(0, cur)) return;
  f32x4 acc[2][2][4][2];
#pragma unroll
  for (int a = 0; a < 2; ++a)
#pragma unroll
    for (int b = 0; b < 2; ++b)
#pragma unroll
      for (int m = 0; m < 4; ++m)
#pragma unroll
        for (int n = 0; n < 2; ++n) acc[a][b][m][n] = (f32x4){0.f, 0.f, 0.f, 0.f};
  bf16x8 At[4][2], B0[2][2], B1[2][2];
  const char* cA = (const char*)g.A + (size_t)cur.pm * tstep; const char* cB = (const char*)g.Bt + (size_t)cur.pn * tstep;
  PG8_STAGE(PG8_SB(0, 0), cB, voffB); PG8_STAGE(PG8_SA(0, 0), cA, voffA); PG8_STAGE(PG8_SB(0, 1), cB + hstepB, voffB); PG8_STAGE(PG8_SA(0, 1), cA + hstep, voffA);
  if (wr == 1) PG8_BAR;
  PG8_WAIT_V(4); PG8_BAR;
  PG8_STAGE(PG8_SB(1, 0), cB + kstep, voffB); PG8_STAGE(PG8_SA(1, 0), cA + kstep, voffA); PG8_STAGE(PG8_SB(1, 1), cB + hstepB + kstep, voffB);
  PG8_WAIT_V(6); PG8_BAR;
  for (;;) {
    const bool has_next = S.next(ui + 1, nxt);
    const char* nA = has_next ? (const char*)g.A + (size_t)nxt.pm * tstep : cA; const char* nB = has_next ? (const char*)g.Bt + (size_t)nxt.pn * tstep : cB;
    for (int t = 0; t < nt; t += 2) {
      const bool last = (t == nt - 2);
      const char* a1 = cA + (size_t)(t + 1) * kstep;
      const char* a2 = last ? nA : cA + (size_t)(t + 2) * kstep; const char* b2 = last ? nB : cB + (size_t)(t + 2) * kstep;
      const char* a3 = a2 + kstep; const char* b3 = b2 + kstep;
      PG8_LDB(B0, 0, 0); PG8_SCHED; PG8_LDA(At, 0, 0); PG8_STAGE(PG8_SA(1, 1), a1 + hstep, voffA);
      PG8_WAIT_L(8); PG8_BAR; PG8_WAIT_L(0); PG8_MMA(0, 0, At, B0); PG8_BAR; PG8_SCHED;
      PG8_LDB(B1, 0, 1); PG8_STAGE(PG8_SB(0, 0), b2, voffB);
      PG8_BAR; PG8_WAIT_L(0); PG8_MMA(0, 1, At, B1); PG8_BAR;
      PG8_LDA(At, 0, 1); PG8_STAGE(PG8_SA(0, 0), a2, voffA);
      PG8_BAR; PG8_WAIT_L(0); PG8_MMA(1, 0, At, B0); PG8_BAR; PG8_SCHED;
      PG8_STAGE(PG8_SB(0, 1), b2 + hstepB, voffB);
      PG8_WAIT_V(6); PG8_BAR; PG8_MMA(1, 1, At, B1); PG8_BAR;
      PG8_LDB(B0, 1, 0); PG8_SCHED; PG8_LDA(At, 1, 0); PG8_STAGE(PG8_SA(0, 1), a2 + hstep, voffA);
      PG8_WAIT_L(8); PG8_BAR; PG8_WAIT_L(0); PG8_MMA(0, 0, At, B0); PG8_BAR; PG8_SCHED;
      PG8_LDB(B1, 1, 1); PG8_STAGE(PG8_SB(1, 0), b3, voffB);
      PG8_BAR; PG8_WAIT_L(0); PG8_MMA(0, 1, At, B1); PG8_BAR;
      PG8_LDA(At, 1, 1); PG8_STAGE(PG8_SA(1, 0), a3, voffA);
      PG8_BAR; PG8_WAIT_L(0); PG8_MMA(1, 0, At, B0); PG8_BAR; PG8_SCHED;
      PG8_STAGE(PG8_SB(1, 1), b3 + hstepB, voffB);
      PG8_WAIT_V(6); PG8_BAR; PG8_MMA(1, 1, At, B1); PG8_BAR;
    }
    E(acc, cur, wr, wc, fr, fq);
    if (!has_next) break;
#pragma unroll
    for (int a = 0; a < 2; ++a)
#pragma unroll
      for (int b = 0; b < 2; ++b)
#pragma unroll
        for (int m = 0; m < 4; ++m)
#pragma unroll
          for (int n = 0; n < 2; ++n) acc[a][b][m][n] = (f32x4){0.f, 0.f, 0.f, 0.f};
    cur = nxt; cA = nA; cB = nB; ++ui;
  }
  PG8_WAIT_V(0);
  if (wr == 0) PG8_BAR;
  PG8_BAR;
#undef PG8_SA
#undef PG8_SB
#undef PG8_STAGE
#undef PG8_LDA
#undef PG8_LDB
#undef PG8_MMA
#undef PG8_WAIT_V
#undef PG8_WAIT_L
#undef PG8_BAR
#undef PG8_SCHED
}

struct EpiRes {
  static constexpr int BMAP = 0;
  const float* src; float* dst; const float* gate;
  DI void operator()(const f32x4 (&acc)[2][2][4][2], const Unit& u, int wr, int wc, int fr, int fq) const {
    asm volatile("" ::: "memory");
    const int row0 = u.pm * BM + wr * 64 + fr, col0 = u.pn * BM + wc * 32 + 4 * fq;
    f32x4 gv[2][2];
#pragma unroll
    for (int bj = 0; bj < 2; ++bj)
#pragma unroll
      for (int n = 0; n < 2; ++n) gv[bj][n] = *(const f32x4*)(gate + col0 + bj * HALF + n * 16);
#pragma unroll
    for (int ai = 0; ai < 2; ++ai) {
      f32x4 sv[4][2][2];
#pragma unroll
      for (int m = 0; m < 4; ++m) {
        const size_t ro = (size_t)(row0 + ai * HALF + m * 16) * DM + col0;
#pragma unroll
        for (int bj = 0; bj < 2; ++bj)
#pragma unroll
          for (int n = 0; n < 2; ++n) sv[m][bj][n] = *(const f32x4*)(src + ro + bj * HALF + n * 16);
      }
#pragma unroll
      for (int m = 0; m < 4; ++m) {
        const size_t ro = (size_t)(row0 + ai * HALF + m * 16) * DM + col0;
#pragma unroll
        for (int bj = 0; bj < 2; ++bj)
#pragma unroll
          for (int n = 0; n < 2; ++n) *(f32x4*)(dst + ro + bj * HALF + n * 16) = sv[m][bj][n] + gv[bj][n] * acc[ai][bj][m][n];
      }
    }
  }
};
struct EpiGU {
  static constexpr int BMAP = 1;
  u16* act;
  DI void operator()(const f32x4 (&acc)[2][2][4][2], const Unit& u, int wr, int wc, int fr, int fq) const {
    asm volatile("" ::: "memory");
    const int row0 = u.pm * BM + wr * 64 + fr, col0 = u.pn * HALF + wc * 32 + 8 * fq;
#pragma unroll
    for (int ai = 0; ai < 2; ++ai)
#pragma unroll
      for (int m = 0; m < 4; ++m) {
        float a[8];
#pragma unroll
        for (int n = 0; n < 2; ++n)
#pragma unroll
          for (int e = 0; e < 4; ++e) {
            float gte = acc[ai][0][m][n][e], up = acc[ai][1][m][n][e];
            a[n * 4 + e] = gte * __builtin_amdgcn_rcpf(1.f + __builtin_amdgcn_exp2f(-gte * LOG2E)) * up;
          }
        *(uint4*)(act + (size_t)(row0 + ai * HALF + m * 16) * FFN + col0) =
            make_uint4(pack_bf16(a[0], a[1]), pack_bf16(a[2], a[3]), pack_bf16(a[4], a[5]), pack_bf16(a[6], a[7]));
      }
  }
};
struct EpiQKV {
  static constexpr int BMAP = 2;
  u16* qkv; const float* qkn; const float* rope; int rowbase;
  DI void operator()(const f32x4 (&acc)[2][2][4][2], const Unit& u, int wr, int wc, int fr, int fq) const {
    asm volatile("" ::: "memory");
    const int chunk = u.pn * 4 + wc;
    const bool isV = (chunk == 8 || chunk == 9 || (chunk >= 18 && chunk <= 21) || chunk >= 30);
    int gi = 0;
    if (chunk < 6) gi = 0; else if (chunk < 8) gi = 1; else if (chunk < 14) gi = 2; else if (chunk < 18) gi = 3;
    else if (chunk < 28) gi = 4; else gi = 5;
    const bool ropeT = (gi == 0 || gi == 1 || gi == 4 || gi == 5) && rowbase == 0;
    const float* gam = qkn + gi * 64;
    const float qs = (gi == 0 || gi == 2 || gi == 4) ? 0.125f * LOG2E : 1.f;
    f32x4 g4[2][2];
#pragma unroll
    for (int bj = 0; bj < 2; ++bj)
#pragma unroll
      for (int n = 0; n < 2; ++n) g4[bj][n] = *(const f32x4*)(gam + 32 * bj + 8 * fq + 4 * n);
#pragma unroll
    for (int ai = 0; ai < 2; ++ai)
#pragma unroll
      for (int m = 0; m < 4; ++m) {
        const int t = u.pm * BM + ai * HALF + wr * 64 + m * 16 + fr;
        int b, pos;
        if (rowbase == 0) { b = t >> 12; pos = t & 4095; } else { b = t >> 8; pos = 4096 + (t & 255); }
        u16* base = qkv + (size_t)(b * 32 + chunk) * LTOT * 64;
        if (isV) {
#pragma unroll
          for (int bj = 0; bj < 2; ++bj)
#pragma unroll
            for (int n = 0; n < 2; ++n)
#pragma unroll
              for (int e = 0; e < 4; ++e) {
                int d = 32 * bj + 8 * fq + 4 * n + e;
                base[(size_t)d * LTOT + pos] = f2bf(acc[ai][bj][m][n][e]);
              }
        } else {
          float ss = 0.f;
#pragma unroll
          for (int bj = 0; bj < 2; ++bj)
#pragma unroll
            for (int n = 0; n < 2; ++n)
#pragma unroll
              for (int e = 0; e < 4; ++e) ss += acc[ai][bj][m][n][e] * acc[ai][bj][m][n][e];
          ss += __shfl_xor(ss, 16);
          ss += __shfl_xor(ss, 32);
          const float rinv = rsqrtf(ss * (1.f / 64.f) + EPSV);
          float o1[8], o2[8];
#pragma unroll
          for (int n = 0; n < 2; ++n) {
            f32x4 cs0 = (f32x4){1.f, 0.f, 1.f, 0.f}, cs1 = cs0;
            if (ropeT) { const float* rp = rope + (size_t)pos * 64 + 2 * (8 * fq + 4 * n); cs0 = *(const f32x4*)rp; cs1 = *(const f32x4*)(rp + 4); }
#pragma unroll
            for (int e = 0; e < 4; ++e) {
              float x1 = acc[ai][0][m][n][e] * (rinv * qs) * g4[0][n][e];
              float x2 = acc[ai][1][m][n][e] * (rinv * qs) * g4[1][n][e];
              float c = (e < 2) ? cs0[2 * e] : cs1[2 * (e - 2)], s = (e < 2) ? cs0[2 * e + 1] : cs1[2 * (e - 2) + 1];
              o1[n * 4 + e] = x1 * c - x2 * s;
              o2[n * 4 + e] = x2 * c + x1 * s;
            }
          }
          u16* dst = base + (size_t)pos * 64 + 8 * fq;
          *(uint4*)(dst) = make_uint4(pack_bf16(o1[0], o1[1]), pack_bf16(o1[2], o1[3]), pack_bf16(o1[4], o1[5]), pack_bf16(o1[6], o1[7]));
          *(uint4*)(dst + 32) = make_uint4(pack_bf16(o2[0], o2[1]), pack_bf16(o2[2], o2[3]), pack_bf16(o2[4], o2[5]), pack_bf16(o2[6], o2[7]));
        }
      }
  }
};
}

constexpr int KROW = 144, VROW = 144;
constexpr int KT_B = 64 * KROW, VT_B = 64 * VROW, KV_B = KT_B + VT_B;
constexpr int RPB_OFF = 2 * KV_B;
constexpr int NAT_C = 384, NAT_B = 256, NAT_A = 384, NAT_LAT = NAT_C + NAT_B + NAT_A, NAT_CTX = 64;

DI void attn_item(const Params& p, int layer, int item, char* smem) {
  const int tid = tidx(), lane = tid & 63, wid = tid >> 6, l32 = lane & 31, h = lane >> 5;
  int mode, b, hh, qb;
  if (item < NAT_C) { mode = 0; b = item / 96; int rem = item % 96; hh = rem >> 4; qb = rem & 15; }
  else if (item < NAT_C + NAT_B) { int it = item - NAT_C; mode = 1; b = it >> 6; hh = (it & 63) >> 4; qb = it & 15; }
  else if (item < NAT_LAT) { int it = item - NAT_C - NAT_B; mode = 2; b = it / 96; int rem = it % 96; hh = rem >> 4; qb = rem & 15; }
  else { int it = item - NAT_LAT; mode = 3; b = it >> 4; hh = it & 15; qb = 0; }

  int qchunk, kchunk, vchunk, head16, t0 = 0, t1 = 0, qpos0 = qb * 256;
  bool hasSink = false; float sinkv = 0.f;
  int maskmode = 0;
  if (mode == 0) { qchunk = 22 + hh; kchunk = 28 + hh / 3; vchunk = 30 + hh / 3; head16 = 10 + hh; t0 = 0; t1 = 64; }
  else if (mode == 1) {
    qchunk = 10 + hh; kchunk = 14 + hh; vchunk = 18 + hh; head16 = 6 + hh; maskmode = 1;
    t0 = min(max(4 * qb - 4, 0), 56); t1 = min(max(4 * qb + 3 - 4, 0), 56) + 8;
  } else if (mode == 2) {
    qchunk = hh; kchunk = 6 + hh / 3; vchunk = 8 + hh / 3; head16 = hh; maskmode = 2;
    t0 = max(0, 4 * qb - 2); t1 = min(64, 4 * qb + 6); hasSink = true; sinkv = p.sink[layer * 6 + hh];
  } else {
    head16 = hh; qpos0 = 4096;
    if (hh < 6) { qchunk = hh; kchunk = 6 + hh / 3; vchunk = 8 + hh / 3; hasSink = true; sinkv = p.sink[layer * 6 + hh]; }
    else if (hh < 10) { int hb = hh - 6; qchunk = 10 + hb; kchunk = 14 + hb; vchunk = 18 + hb; }
    else { int hc = hh - 10; qchunk = 22 + hc; kchunk = 28 + hc / 3; vchunk = 30 + hc / 3; }
  }
  const int n_it = 4 + (t1 - t0);
  const u16* Qb = p.QKV + (size_t)(b * 32 + qchunk) * LTOT * 64;
  const u16* Kb = p.QKV + (size_t)(b * 32 + kchunk) * LTOT * 64;
  const u16* Vb = p.QKV + (size_t)(b * 32 + vchunk) * LTOT * 64;
  float* s_rpb = (float*)(smem + RPB_OFF);
  if (mode == 1) {
    const float* rp = p.rpb + (size_t)(layer * 4 + hh) * 465;
    for (int e = tid; e < 465; e += NTHR) s_rpb[e] = rp[e] * LOG2E;
  }

  const int qpos = qpos0 + wid * 32 + l32;
  bf16x8 qf[4];
#pragma unroll
  for (int s = 0; s < 4; ++s) qf[s] = *(const bf16x8*)(Qb + (size_t)qpos * 64 + s * 16 + h * 8);

  f32x16 o0, o1;
#pragma unroll
  for (int r = 0; r < 16; ++r) { o0[r] = 0.f; o1[r] = 0.f; }
  const int btype = (mode == 3) ? (hh < 6 ? 0 : (hh < 10 ? 1 : 2)) : (mode == 0 ? 2 : (mode == 1 ? 1 : 0));
  float m_fix = p.bounds[layer * 8 + btype];
  if (mode == 1) m_fix += p.bounds[layer * 8 + 4 + hh];
  f32x16 cinit, lacc;
#pragma unroll
  for (int r = 0; r < 16; ++r) { cinit[r] = -m_fix; lacc[r] = 0.f; }
  const bf16x8 ones = {(short)0x3F80, (short)0x3F80, (short)0x3F80, (short)0x3F80, (short)0x3F80, (short)0x3F80, (short)0x3F80, (short)0x3F80};

  const int lr = tid >> 3, lc = tid & 7;
  uint4 ka0, va0, kb0, vb0;
#define TILE_OF(it) ((it) < 4 ? 64 + (it) : t0 + (it) - 4)
#define AGLOAD(K0, V0, tile)                                                           \
  {                                                                                    \
    K0 = *(const uint4*)(Kb + (size_t)((tile) * 64 + lr) * 64 + lc * 8);               \
    V0 = *(const uint4*)(Vb + (size_t)(lr) * LTOT + (tile) * 64 + lc * 8);             \
  }
#define ASWRITE(K0, V0, buf)                                                           \
  {                                                                                    \
    *(uint4*)(smem + (buf) * KV_B + (lr) * KROW + lc * 16) = K0;                       \
      \
                       \
    char* vd = smem + (buf) * KV_B + KT_B + (lr) * VROW + (16 * (lc >> 1) + 4 * (lc & 1)) * 2; \
    *(uint2*)(vd) = make_uint2(V0.x, V0.y);                                            \
    *(uint2*)(vd + 16) = make_uint2(V0.z, V0.w);                                       \
  }

  const int tq = qb * 256 + wid * 32 + l32;
  auto compute = [&](const int bufsel, const int tile) {
    bool skip = false;
    if (tile < 64) {
      if (maskmode == 1) {
        int qr = (qb * 256 + wid * 32) >> 6;
        int krw = min(max(qr - 4, 0), 56);
        skip = (tile < krw) || (tile >= krw + 8);
      } else if (maskmode == 2) {
        int q0w = qb * 256 + wid * 32, tk0 = tile * 64;
        skip = (tk0 > q0w + 31 + 128) || (tk0 + 63 < q0w - 128);
      }
    }
    if (!skip) {
      const char* sK = smem + bufsel * KV_B;
      const char* sV = sK + KT_B;
      f32x16 S[2];
      __builtin_amdgcn_s_setprio(1);
#pragma unroll
      for (int kt = 0; kt < 2; ++kt) {
#pragma unroll
        for (int s = 0; s < 4; ++s) {
          bf16x8 kf = *(const bf16x8*)(sK + (kt * 32 + l32) * KROW + s * 32 + h * 16);
          S[kt] = MFMA32(kf, qf[s], s == 0 ? cinit : S[kt]);
        }
      }
      __builtin_amdgcn_s_setprio(0);
      if (tile < 64 && maskmode == 1) {
        int qr = tq >> 6, qc = tq & 63;
        int ws = min(max(qc - 8, 0), 48);
        int dr = tile - qr + 7;
#pragma unroll
        for (int kt = 0; kt < 2; ++kt)
#pragma unroll
          for (int r = 0; r < 16; ++r) {
            int kc = kt * 32 + crow(r, h);
            bool ok = (unsigned)(kc - ws) < 16u;
            int bi = ok ? (dr * 31 + kc - qc + 15) : 0;
            float bv = s_rpb[bi];
            S[kt][r] = ok ? (S[kt][r] + bv) : -INFINITY;
          }
      } else if (tile < 64 && maskmode == 2) {
#pragma unroll
        for (int kt = 0; kt < 2; ++kt)
#pragma unroll
          for (int r = 0; r < 16; ++r) {
            int tk = tile * 64 + kt * 32 + crow(r, h);
            int dd = tq - tk;
            bool ok = (dd <= 128) && (dd >= -128);
            S[kt][r] = ok ? S[kt][r] : -INFINITY;
          }
      }
#pragma unroll
      for (int r = 0; r < 16; ++r) {
        S[0][r] = __builtin_amdgcn_exp2f(S[0][r]);
        S[1][r] = __builtin_amdgcn_exp2f(S[1][r]);
      }
#pragma unroll
      for (int kt = 0; kt < 2; ++kt)
#pragma unroll
        for (int s2 = 0; s2 < 2; ++s2) {
          uint4 pw;
          pw.x = pack_bf16(S[kt][8 * s2 + 0], S[kt][8 * s2 + 1]);
          pw.y = pack_bf16(S[kt][8 * s2 + 2], S[kt][8 * s2 + 3]);
          pw.z = pack_bf16(S[kt][8 * s2 + 4], S[kt][8 * s2 + 5]);
          pw.w = pack_bf16(S[kt][8 * s2 + 6], S[kt][8 * s2 + 7]);
          bf16x8 pf = __builtin_bit_cast(bf16x8, pw);
          const int koff = (kt * 32 + 16 * s2 + 8 * h) * 2;
          {
            bf16x8 vf = *(const bf16x8*)(sV + l32 * VROW + koff);
            o0 = MFMA32(vf, pf, o0);
            lacc = MFMA32(ones, pf, lacc);
          }
          {
            bf16x8 vf = *(const bf16x8*)(sV + (32 + l32) * VROW + koff);
            o1 = MFMA32(vf, pf, o1);
          }
        }
    }
  };

  AGLOAD(ka0, va0, TILE_OF(0));
  if (n_it > 1) { AGLOAD(kb0, vb0, TILE_OF(1)); }
  ASWRITE(ka0, va0, 0);
  if (n_it > 2) { AGLOAD(ka0, va0, TILE_OF(2)); }
  __syncthreads();
  for (int it = 0; it < n_it; it += 2) {
    if (it + 1 < n_it) { ASWRITE(kb0, vb0, 1); }
    if (it + 3 < n_it) { AGLOAD(kb0, vb0, TILE_OF(it + 3)); }
    __builtin_amdgcn_sched_barrier(0);
    compute(0, TILE_OF(it));
    __syncthreads();
    if (it + 1 < n_it) {
      if (it + 2 < n_it) { ASWRITE(ka0, va0, 0); }
      if (it + 4 < n_it) { AGLOAD(ka0, va0, TILE_OF(it + 4)); }
      __builtin_amdgcn_sched_barrier(0);
      compute(1, TILE_OF(it + 1));
      __syncthreads();
    }
  }
#undef AGLOAD
#undef ASWRITE
#undef TILE_OF

  float l_tot = lacc[0];
  if (hasSink) l_tot += __builtin_amdgcn_exp2f(sinkv * LOG2E - m_fix);
  float inv = 1.f / l_tot;
  int T = (mode == 3) ? (TLAT + b * 256 + (qpos - 4096)) : (b * 4096 + qpos);
  u16* od = p.O + (size_t)T * LDK + head16 * 64;
#pragma unroll
  for (int g = 0; g < 4; ++g) {
    int d0 = 8 * g + 4 * h;
    *(uint2*)(od + d0) = make_uint2(pack_bf16(o0[4 * g] * inv, o0[4 * g + 1] * inv), pack_bf16(o0[4 * g + 2] * inv, o0[4 * g + 3] * inv));
    *(uint2*)(od + 32 + d0) = make_uint2(pack_bf16(o1[4 * g] * inv, o1[4 * g + 1] * inv), pack_bf16(o1[4 * g + 2] * inv, o1[4 * g + 3] * inv));
  }
}

DI void run_gphase(const Params& p, int g, char* smem, int coff = 0) {
  using namespace pg8;
  LAS unsigned char* lds = (LAS unsigned char*)smem;
  const int layer = (g - 1) / 7, ph = (g - 1) % 7 + 1;
  const bool hasc = (g + 1 <= 23);
  const int cl = g / 7;
  const int bid = blockIdx.x, nb = gridDim.x;
  const float* xin_lat; const float* xin_ctx; float* xo_lat = p.out; float* xo_ctx = p.xctx;
  { const float* a_ = p.x; const float* c_ = p.ctx; asm volatile("" : "+s"(a_), "+s"(c_));
    float* b_ = p.out; float* d_ = p.xctx; asm volatile("" : "+s"(b_), "+s"(d_));
    xin_lat = (layer == 0) ? a_ : (const float*)b_; xin_ctx = (cl == 0) ? c_ : (const float*)d_; xo_lat = b_; xo_ctx = d_; }
  switch (ph) {
    case 1: {
      if (hasc) {
        OneUnit S; S.u.pm = bid & 3; S.u.pn = bid >> 2; S.valid = bid < 32;
        EpiQKV E; E.qkv = p.QKV; E.qkn = p.qk_norm + cl * 6 * 64; E.rope = p.rope; E.rowbase = TLAT;
        gemm_phase(lds, Gemm{p.H + (size_t)TLAT * LDK, p.wt_in + (size_t)cl * INW * LDK, DM}, S, E);
      }
      norm_dyn(p, layer, 0, 0, TLAT, &p.counters[32 + g + coff]);
    } break;
    case 2: {
      TileOrder S; S.init(64, 8, nb, bid, 0);
      EpiQKV E; E.qkv = p.QKV; E.qkn = p.qk_norm + layer * 6 * 64; E.rope = p.rope; E.rowbase = 0;
      gemm_phase(lds, Gemm{p.H, p.wt_in + (size_t)layer * INW * LDK, DM}, S, E);
      if (hasc)
        for (int i = bid; i < NAT_CTX; i += nb) attn_item(p, cl, NAT_LAT + i, smem);
    } break;
    case 3: {
      const int nctx = hasc ? 16 : 0;
      for (int it = grab(&p.counters[g + coff]); it < NAT_LAT + nctx; it = grab(&p.counters[g + coff])) {
        if (it < NAT_C) attn_item(p, layer, it, smem);
        else if (it < NAT_C + nctx) {
          int j = it - NAT_C;
          OneUnit S; S.u.pm = j & 3; S.u.pn = j >> 2; S.valid = true;
          EpiRes E; E.src = xin_ctx; E.dst = xo_ctx; E.gate = p.mod + ((size_t)cl * 5 + 4) * 6144 + 2 * 1024;
          gemm_phase(lds, Gemm{p.O + (size_t)TLAT * LDK, p.wt_out + (size_t)cl * DM * LDK, DM}, S, E);
        } else attn_item(p, layer, it - nctx, smem);
      }
    } break;
    case 4: {
      TileOrder S; S.init(64, 4, nb, bid, 0);
      Unit u0;
      for (int i = 0; S.next(i, u0); ++i) {
        OneUnit S1; S1.u = u0; S1.valid = true;
        EpiRes E; E.src = xin_lat; E.dst = xo_lat; E.gate = p.mod + ((size_t)layer * 5 + (u0.pm >> 4)) * 6144 + 2 * 1024;
        gemm_phase(lds, Gemm{p.O, p.wt_out + (size_t)layer * DM * LDK, DM}, S1, E);
      }
      if (hasc) norm_static(p, cl, 1, TLAT, TTOT);
    } break;
    case 5: {
      if (hasc) {
        OneUnit S; S.u.pm = bid & 3; S.u.pn = bid >> 2; S.valid = bid < 88;
        EpiGU E; E.act = p.ACT + (size_t)TLAT * LDF;
        gemm_phase(lds, Gemm{p.H + (size_t)TLAT * LDK, p.wt_gu + (size_t)cl * GUW * LDK, DM}, S, E);
      }
      norm_dyn(p, layer, 1, 0, TLAT, &p.counters[32 + g + coff]);
    } break;
    case 6: {
      if (hasc) {
        int j = (nb == 256) ? bid - 240 : bid;
        OneUnit S; S.u.pm = j & 3; S.u.pn = (j >> 2) & 3; S.valid = (j >= 0 && j < 16);
        EpiRes E; E.src = xo_ctx; E.dst = xo_ctx; E.gate = p.mod + ((size_t)cl * 5 + 4) * 6144 + 5 * 1024;
        gemm_phase(lds, Gemm{p.ACT + (size_t)TLAT * LDF, p.wt_down + (size_t)cl * DM * LDF, FFN}, S, E);
      }
      TileOrder S; S.init(64, 22, nb, bid, (hasc && nb == 256) ? 1 : 0);
      EpiGU E; E.act = p.ACT;
      gemm_phase(lds, Gemm{p.H, p.wt_gu + (size_t)layer * GUW * LDK, DM}, S, E);
    } break;
    case 7: {
      TileOrder S; S.init(64, 4, nb, bid, 0);
      Unit u0;
      for (int i = 0; S.next(i, u0); ++i) {
        OneUnit S1; S1.u = u0; S1.valid = true;
        EpiRes E; E.src = xo_lat; E.dst = xo_lat; E.gate = p.mod + ((size_t)layer * 5 + (u0.pm >> 4)) * 6144 + 5 * 1024;
        gemm_phase(lds, Gemm{p.ACT, p.wt_down + (size_t)layer * DM * LDF, FFN}, S1, E);
      }
      if (hasc) norm_static(p, cl, 0, TLAT, TTOT);
    } break;
  }
}

#define XB_XCNT(j)  (256  + 64 * (j))
#define XB_XSUB(j)  (1280 + 64 * (j))
#define XB_XGEN(j)  (2304 + 64 * (j))
#define XB_TOP      3328
#define XB_TOPGEN   3392
#define XCD_BAR_WORDS 3456
#define LAS __attribute__((address_space(3)))
DI unsigned xb_ld(unsigned* p) { return __hip_atomic_load(p, __ATOMIC_RELAXED, __HIP_MEMORY_SCOPE_AGENT); }
DI unsigned xb_add(unsigned* p, unsigned v) { return __hip_atomic_fetch_add(p, v, __ATOMIC_RELAXED, __HIP_MEMORY_SCOPE_AGENT); }
DI unsigned xb_xcc_id() { return (unsigned)__builtin_amdgcn_s_getreg((3 << 11) | 20) & 0xFu; }
struct XcdBarrier { unsigned* bar; unsigned x; volatile LAS unsigned* st; };
DI XcdBarrier xcd_barrier_post(unsigned* bar, volatile LAS unsigned* st) {
  XcdBarrier b; b.bar = bar; b.x = xb_xcc_id(); b.st = st;
  if (threadIdx.x == 0) (void)xb_add(&bar[XB_XCNT(b.x)], 1u);
  return b;
}
DI void xcd_barrier_complete(unsigned* bar, unsigned x, unsigned& nloc, unsigned& nx) {
  const unsigned G = gridDim.x;
  unsigned sum, cnt, mine;
  for (;;) {
    sum = 0u; cnt = 0u; mine = 0u;
#pragma unroll
    for (unsigned j = 0; j < 16; ++j) { const unsigned c = xb_ld(&bar[XB_XCNT(j)]); sum += c; cnt += (c > 0u) ? 1u : 0u; mine = (j == x) ? c : mine; }
    if (sum == G) break;
    __builtin_amdgcn_s_sleep(1);
  }
  nloc = mine > 0u ? mine : 1u; nx = cnt > 0u ? cnt : 1u;
}
DI void xcd_barrier(const XcdBarrier& b) {
  asm volatile("s_waitcnt vmcnt(0)" ::: "memory");
  __syncthreads();
  if (threadIdx.x == 0) {
    unsigned* bar = b.bar;
    unsigned bx = b.x;
    asm volatile("" : "+s"(bx));
    __builtin_amdgcn_s_waitcnt(0);
    unsigned nloc = b.st[0], nx = b.st[1];
    if (nloc == 0u) { xcd_barrier_complete(bar, bx, nloc, nx); b.st[0] = nloc; b.st[1] = nx; }
    const unsigned old = xb_add(&bar[XB_XSUB(bx)], 1u);
    const unsigned gen = old / nloc;
    if (old + 1u == (gen + 1u) * nloc) {
      __builtin_amdgcn_fence(__ATOMIC_RELEASE, "agent");
      asm volatile("s_waitcnt vmcnt(0)" ::: "memory");
      const unsigned og = xb_add(&bar[XB_TOP], 1u);
      const unsigned tg = og / nx;
      if (og + 1u == (tg + 1u) * nx) xb_add(&bar[XB_TOPGEN], 1u);
      else { while (xb_ld(&bar[XB_TOPGEN]) == tg) __builtin_amdgcn_s_sleep(1); }
      __builtin_amdgcn_fence(__ATOMIC_ACQUIRE, "agent");
      xb_add(&bar[XB_XGEN(bx)], 1u);
      asm volatile("s_waitcnt vmcnt(0)" ::: "memory");
    } else {
      while (xb_ld(&bar[XB_XGEN(bx)]) == gen) __builtin_amdgcn_s_sleep(1);
      __builtin_amdgcn_fence(__ATOMIC_ACQUIRE, "agent");
      asm volatile("s_waitcnt vmcnt(0)" ::: "memory");
    }
  }
  __syncthreads();
}


__global__ void __launch_bounds__(512, 2) fwd_megakernel(Params p) {
  extern __shared__ __attribute__((aligned(16))) unsigned char dsm[];
  char* smem = (char*)dsm;
  cg::grid_group grid = cg::this_grid();
  if (threadIdx.x == 0) *(uint4*)(dsm + 131072) = make_uint4(0u, 0u, 0u, 0u);
  __syncthreads();
  XcdBarrier xb = xcd_barrier_post(p.counters + 1024, (volatile LAS unsigned*)(dsm + 131072));
  phase0(p, smem);
  grid.sync();
  norm_static(p, 0, 0, TLAT, TTOT);
  xcd_barrier(xb);
  for (int g = 1; g <= 7 * NLAYER; ++g) {
    run_gphase(p, g, smem);
#ifdef PROBE_DOUBLE
    if ((g - 1) % 7 + 1 == PROBE_DOUBLE) { xcd_barrier(xb); run_gphase(p, g, smem, 100); }
#endif
    if (g < 7 * NLAYER) xcd_barrier(xb);
  }
}

extern "C" void kernel_launch(void* const* d_in, const int* in_sizes, int n_in, void* d_out, int out_size, void* d_ws,
                              size_t ws_size, hipStream_t stream) {
  Params p{};
  p.x = (const float*)d_in[0]; p.c = (const float*)d_in[1]; p.ctx = (const float*)d_in[2]; p.c_ctx = (const float*)d_in[3];
  p.w_mod = (const float*)d_in[4]; p.b_mod = (const float*)d_in[5]; p.norm_attn = (const float*)d_in[6];
  p.norm_ffn = (const float*)d_in[7]; p.w_in = (const float*)d_in[8]; p.qk_norm = (const float*)d_in[9];
  p.sink = (const float*)d_in[10]; p.rpb = (const float*)d_in[11]; p.w_out = (const float*)d_in[12];
  p.w_gate = (const float*)d_in[13]; p.w_up = (const float*)d_in[14]; p.w_down = (const float*)d_in[15];
  p.out = (float*)d_out;
  char* w = (char*)d_ws;
  size_t off = 0;
  auto take = [&](size_t bytes) { char* r = w + off; off += (bytes + 255) & ~(size_t)255; return r; };
  p.counters = (unsigned*)take(4096 + XCD_BAR_WORDS * 4);
  p.wt_in = (u16*)take((size_t)NLAYER * INW * LDK * 2);
  p.wt_out = (u16*)take((size_t)NLAYER * DM * LDK * 2);
  p.wt_gu = (u16*)take((size_t)NLAYER * GUW * LDK * 2);
  p.wt_down = (u16*)take((size_t)NLAYER * DM * LDF * 2);
  p.H = (u16*)take((size_t)TTOT * LDK * 2);
  p.mod = (float*)take((size_t)NLAYER * 5 * 6144 * 4);
  p.xctx = (float*)take((size_t)TCTX * DM * 4);
  p.rope = (float*)take((size_t)SEQL * 32 * 2 * 4);
  p.bounds = (float*)take(256);
  p.QKV = (u16*)take((size_t)NBATCH * 32 * LTOT * 64 * 2);
  p.O = (u16*)take((size_t)TTOT * LDK * 2);
  p.ACT = p.QKV;

  hipMemsetAsync(p.counters, 0, 4096 + XCD_BAR_WORDS * 4, stream);

  static int grid_blocks = 0;
  if (!grid_blocks) {
    int dev = 0, cus = 0, per_cu = 0;
    hipGetDevice(&dev);
    hipDeviceGetAttribute(&cus, hipDeviceAttributeMultiprocessorCount, dev);
    hipFuncSetAttribute((const void*)fwd_megakernel, hipFuncAttributeMaxDynamicSharedMemorySize, DYN_LDS);
    hipOccupancyMaxActiveBlocksPerMultiprocessor(&per_cu, fwd_megakernel, NTHR, DYN_LDS);
    if (per_cu > 1) per_cu = 1;
    if (per_cu < 1) per_cu = 1;
    grid_blocks = cus * per_cu;
  }
  void* args[] = {&p};
  hipError_t e = hipLaunchCooperativeKernel((void*)fwd_megakernel, dim3(grid_blocks), dim3(NTHR), args, DYN_LDS, stream);
  if (e != hipSuccess) fprintf(stderr, "cooperative launch failed: %s (grid %d)\n", hipGetErrorString(e), grid_blocks);
}
```

```cpp
#include <hip/hip_runtime.h>
#include <hip/hip_cooperative_groups.h>
#include <cstdio>
namespace cg = cooperative_groups;

typedef unsigned short u16;
typedef __attribute__((ext_vector_type(8))) short bf16x8;
typedef __attribute__((ext_vector_type(16))) float f32x16;
typedef __attribute__((ext_vector_type(4))) float f32x4;
typedef __attribute__((ext_vector_type(2))) float f32x2;
typedef __attribute__((ext_vector_type(2))) __bf16 bf16x2_t;
#define DI __device__ __forceinline__
#define LAS __attribute__((address_space(3)))
#define MFMA32(a, b, c) __builtin_amdgcn_mfma_f32_32x32x16_bf16((a), (b), (c), 0, 0, 0)

constexpr int DM = 1024, NBATCH = 4, SEQL = 4096, CTXL = 256, LTOT = 4352;
constexpr int TLAT = NBATCH * SEQL, TCTX = NBATCH * CTXL, TTOT = TLAT + TCTX;
constexpr int NLAYER = 4, INW = 2048, FFN = 2816, GUW = 2 * FFN;
constexpr int LDK = DM, LDF = FFN;
constexpr int NTHR = 512;
constexpr int DYN_LDS = 131072 + 64;
constexpr float EPSV = 1e-6f;
constexpr float LOG2E = 1.4426950408889634f;

struct Params {
  const float *x, *c, *ctx, *c_ctx, *w_mod, *b_mod, *norm_attn, *norm_ffn, *w_in, *qk_norm, *sink, *rpb,
              *w_out, *w_gate, *w_up, *w_down;
  float* out;
  u16 *wt_in, *wt_out, *wt_gu, *wt_down, *H, *QKV, *O, *ACT;
  float *mod, *xctx, *rope, *bounds;
  unsigned* counters;
};

DI unsigned pack_bf16(float a, float b) {
  f32x2 v = {a, b};
  bf16x2_t r = __builtin_convertvector(v, bf16x2_t);
  return __builtin_bit_cast(unsigned, r);
}
DI u16 f2bf(float a) { return (u16)(pack_bf16(a, 0.f) & 0xffffu); }
DI int tidx() { int t = threadIdx.x; asm volatile("" : "+v"(t)); return t; }
DI int crow(int r, int h) { return (r & 3) + 8 * (r >> 2) + 4 * h; }

DI int grab(unsigned* ctr) {
  __shared__ int s_grab;
  if (threadIdx.x == 0) s_grab = (int)atomicAdd(ctr, 1u);
  __syncthreads();
  int v = s_grab;
  __syncthreads();
  return v;
}

DI void phase0(const Params& p, char* smem) {
  const int tid = tidx();
  constexpr int NWP = NLAYER * 2880 / 2, NMOD = NLAYER * 96, NROPE = 256, NBND = 1;
  const float* w_in_ = p.w_in; const float* w_out_ = p.w_out; const float* w_gate_ = p.w_gate;
  const float* w_up_ = p.w_up; const float* w_down_ = p.w_down;
  asm volatile("" : "+v"(w_in_), "+v"(w_out_), "+v"(w_gate_), "+v"(w_up_), "+v"(w_down_));
  {
    const int half = tid >> 8, t = tid & 255;
    float* tile = (float*)(smem + half * 16640);
    const float* src; int N, k0, n0, Kd, up, kind; u16* dst;
    const float* nsrc = nullptr; int nN = 0, nk0 = 0, nn0 = 0, nKd = 0, nup = 0, nkind = 0; u16* ndst = nullptr;
    float4 cur[4], nxt[4];
#define WDECODE(item_, src_, N_, k0_, n0_, Kd_, up_, kind_, dst_)                                                              \
    {                                                                                                                          \
      const int it2_ = (item_) * 2 + half; const int layer_ = it2_ / 2880; int idx_ = it2_ % 2880; up_ = 0;                    \
      if (idx_ < 512) { kind_ = 0; k0_ = (idx_ >> 5) * 64; n0_ = (idx_ & 31) * 64; src_ = w_in_ + (size_t)layer_ * DM * INW; N_ = INW; dst_ = p.wt_in + (size_t)layer_ * INW * DM; Kd_ = DM; } \
      else if (idx_ < 768) { idx_ -= 512; kind_ = 0; k0_ = (idx_ >> 4) * 64; n0_ = (idx_ & 15) * 64; src_ = w_out_ + (size_t)layer_ * DM * DM; N_ = DM; dst_ = p.wt_out + (size_t)layer_ * DM * DM; Kd_ = DM; } \
      else if (idx_ < 2176) { idx_ -= 768; up_ = idx_ >= 704; if (up_) idx_ -= 704; kind_ = 1; k0_ = (idx_ / 44) * 64; n0_ = (idx_ % 44) * 64; \
        src_ = (up_ ? w_up_ : w_gate_) + (size_t)layer_ * DM * FFN; N_ = FFN; dst_ = p.wt_gu + (size_t)layer_ * GUW * DM; Kd_ = DM; } \
      else { idx_ -= 2176; kind_ = 0; k0_ = (idx_ >> 4) * 64; n0_ = (idx_ & 15) * 64; src_ = w_down_ + (size_t)layer_ * FFN * DM; N_ = DM; dst_ = p.wt_down + (size_t)layer_ * DM * FFN; Kd_ = FFN; } \
    }
#define WLOAD(v_, src_, N_, k0_, n0_)                                                                                          \
    _Pragma("unroll") for (int ps = 0; ps < 4; ++ps) {                                                                         \
      int kk = (t >> 4) + 16 * ps, nn = (t & 15) * 4;                                                                          \
      v_[ps] = *(const float4*)(src_ + (size_t)(k0_ + kk) * N_ + n0_ + nn);                                                    \
    }
    int item = blockIdx.x;
    if (item < NWP) { WDECODE(item, src, N, k0, n0, Kd, up, kind, dst); WLOAD(cur, src, N, k0, n0); }
    for (; item < NWP; item += gridDim.x) {
      const int nitem = item + gridDim.x;
      if (nitem < NWP) { WDECODE(nitem, nsrc, nN, nk0, nn0, nKd, nup, nkind, ndst); WLOAD(nxt, nsrc, nN, nk0, nn0); }
#pragma unroll
      for (int ps = 0; ps < 4; ++ps) {
        int kk = (t >> 4) + 16 * ps, nn = (t & 15) * 4;
        tile[kk * 65 + nn] = cur[ps].x; tile[kk * 65 + nn + 1] = cur[ps].y; tile[kk * 65 + nn + 2] = cur[ps].z; tile[kk * 65 + nn + 3] = cur[ps].w;
      }
      __syncthreads();
      {
        int n = t >> 2, kc = (t & 3) * 16;
        unsigned w[8];
#pragma unroll
        for (int j = 0; j < 8; ++j) w[j] = pack_bf16(tile[(kc + 2 * j) * 65 + n], tile[(kc + 2 * j + 1) * 65 + n]);
        int col = n0 + n;
        int row = kind ? ((col >> 7) * 256 + up * 128 + (col & 127)) : col;
        uint4* d = (uint4*)(dst + (size_t)row * Kd + k0 + kc);
        d[0] = make_uint4(w[0], w[1], w[2], w[3]);
        d[1] = make_uint4(w[4], w[5], w[6], w[7]);
      }
      __syncthreads();
#pragma unroll
      for (int ps = 0; ps < 4; ++ps) cur[ps] = nxt[ps];
      src = nsrc; N = nN; k0 = nk0; n0 = nn0; Kd = nKd; up = nup; kind = nkind; dst = ndst;
    }
#undef WDECODE
#undef WLOAD
  }
  for (int item = NWP + blockIdx.x; item < NWP + NMOD + NROPE + NBND; item += gridDim.x) {
    if (false) {
    } else if (item < NWP + NMOD) {
      int it = item - NWP, layer = it / 96, cg0 = (it % 96) * 64;
      float* sc = (float*)smem;
      float* red = sc + 5 * 1024;
      for (int e = tid; e < 5 * 1024; e += NTHR) {
        int mb = e >> 10, k = e & 1023;
        float v = (mb < 4) ? p.c[mb * 1024 + k] : p.c_ctx[k];
        sc[e] = v / (1.f + __expf(-v));
      }
      __syncthreads();
      int col = cg0 + (tid & 63), kq = tid >> 6;
      const float* w = p.w_mod + (size_t)layer * DM * 6144 + col;
      float a0 = 0, a1 = 0, a2 = 0, a3 = 0, a4 = 0;
#pragma unroll 32
      for (int k = kq * 128; k < kq * 128 + 128; ++k) {
        float wv = w[(size_t)k * 6144];
        a0 += sc[k] * wv; a1 += sc[1024 + k] * wv; a2 += sc[2048 + k] * wv; a3 += sc[3072 + k] * wv; a4 += sc[4096 + k] * wv;
      }
      int c64 = tid & 63;
      red[(kq * 5 + 0) * 64 + c64] = a0; red[(kq * 5 + 1) * 64 + c64] = a1; red[(kq * 5 + 2) * 64 + c64] = a2;
      red[(kq * 5 + 3) * 64 + c64] = a3; red[(kq * 5 + 4) * 64 + c64] = a4;
      __syncthreads();
      for (int e = tid; e < 5 * 64; e += NTHR) {
        int mb = e >> 6, cc = e & 63;
        float s = 0.f;
#pragma unroll
        for (int q = 0; q < 8; ++q) s += red[(q * 5 + mb) * 64 + cc];
        p.mod[((size_t)layer * 5 + mb) * 6144 + cg0 + cc] = s + p.b_mod[layer * 6144 + cg0 + cc];
      }
      __syncthreads();
    } else if (item >= NWP + NMOD + NROPE) {
      unsigned* mx = (unsigned*)smem;
      for (int e = tid; e < NLAYER * 10; e += NTHR) mx[e] = 0u;
      __syncthreads();
      for (int e = tid; e < NLAYER * 6 * 64; e += NTHR) atomicMax(&mx[(e / 384) * 10 + (e % 384) / 64], __float_as_uint(fabsf(p.qk_norm[e])));
      for (int e = tid; e < NLAYER * 4 * 465; e += NTHR) atomicMax(&mx[(e / 1860) * 10 + 6 + (e % 1860) / 465], __float_as_uint(fabsf(p.rpb[e])));
      __syncthreads();
      if (tid < NLAYER * 8) {
        int l = tid >> 3, j = tid & 7; float v = 0.f;
        if (j < 3) v = 0.125f * LOG2E * 64.f * 1.02f * __uint_as_float(mx[l * 10 + 2 * j]) * __uint_as_float(mx[l * 10 + 2 * j + 1]);
        else if (j >= 4) v = LOG2E * __uint_as_float(mx[l * 10 + 6 + (j - 4)]);
        p.bounds[tid] = v;
      }
      __syncthreads();
    } else {
      int e = (item - NWP - NMOD) * NTHR + tid;
      int t = e >> 5, pi = e & 31;
      float pos = (pi < 16) ? (float)(t >> 6) : (float)(t & 63);
      float inv = exp2f(-(float)(pi & 15) * (13.287712379549449f / 16.0f));
      float ang = pos * inv;
      p.rope[2 * e] = __cosf(ang);
      p.rope[2 * e + 1] = __sinf(ang);
    }
  }
}

DI const float* xrow_src(const Params& p, int layer, int t) {
  const float* a = p.x; const float* b = p.out; const float* c = p.ctx; const float* d = p.xctx;
  asm volatile("" : "+v"(a), "+v"(b), "+v"(c), "+v"(d));
  if (t < TLAT) return (layer == 0 ? a : b) + (size_t)t * DM;
  return (layer == 0 ? c : d) + (size_t)(t - TLAT) * DM;
}
DI float* xrow_dst(const Params& p, int t) {
  float* b = p.out; float* d = p.xctx;
  asm volatile("" : "+v"(b), "+v"(d));
  if (t < TLAT) return b + (size_t)t * DM;
  return d + (size_t)(t - TLAT) * DM;
}
DI int mb_of(int t) { return t < TLAT ? (t >> 12) : 4; }

DI void norm_row(const Params& p, int layer, int which, int t, int lane) {
  const float* g = (which ? p.norm_ffn : p.norm_attn) + layer * DM;
  const float* xr = which ? (const float*)xrow_dst(p, t) : xrow_src(p, layer, t);
  const float* md = p.mod + ((size_t)layer * 5 + mb_of(t)) * 6144 + (which ? 3 * 1024 : 0);
  float4 v[4];
  float ss = 0.f;
#pragma unroll
  for (int j = 0; j < 4; ++j) {
    v[j] = *(const float4*)(xr + lane * 4 + 256 * j);
    ss += v[j].x * v[j].x + v[j].y * v[j].y + v[j].z * v[j].z + v[j].w * v[j].w;
  }
#pragma unroll
  for (int o = 32; o >= 1; o >>= 1) ss += __shfl_xor(ss, o);
  float r = rsqrtf(ss * (1.f / 1024.f) + EPSV);
#pragma unroll
  for (int j = 0; j < 4; ++j) {
    int col = lane * 4 + 256 * j;
    float4 gg = *(const float4*)(g + col);
    float4 sh = *(const float4*)(md + col);
    float4 sc = *(const float4*)(md + 1024 + col);
    float o0 = v[j].x * r * gg.x * (1.f + sc.x) + sh.x;
    float o1 = v[j].y * r * gg.y * (1.f + sc.y) + sh.y;
    float o2 = v[j].z * r * gg.z * (1.f + sc.z) + sh.z;
    float o3 = v[j].w * r * gg.w * (1.f + sc.w) + sh.w;
    *(uint2*)(p.H + (size_t)t * LDK + col) = make_uint2(pack_bf16(o0, o1), pack_bf16(o2, o3));
  }
}
template <int R>
DI void norm_rows(const Params& p, int layer, int which, int t0, int tstep, int lane) {
  const float* g = (which ? p.norm_ffn : p.norm_attn) + layer * DM;
  const float* md = p.mod + ((size_t)layer * 5 + mb_of(t0)) * 6144 + (which ? 3 * 1024 : 0);
  float4 v[R][4];
  float ss[R];
#pragma unroll
  for (int r = 0; r < R; ++r) {
    const float* xr = which ? (const float*)xrow_dst(p, t0 + r * tstep) : xrow_src(p, layer, t0 + r * tstep);
#pragma unroll
    for (int j = 0; j < 4; ++j) v[r][j] = *(const float4*)(xr + lane * 4 + 256 * j);
  }
#pragma unroll
  for (int r = 0; r < R; ++r) {
    ss[r] = 0.f;
#pragma unroll
    for (int j = 0; j < 4; ++j) ss[r] += v[r][j].x * v[r][j].x + v[r][j].y * v[r][j].y + v[r][j].z * v[r][j].z + v[r][j].w * v[r][j].w;
  }
#pragma unroll
  for (int o = 32; o >= 1; o >>= 1)
#pragma unroll
    for (int r = 0; r < R; ++r) ss[r] += __shfl_xor(ss[r], o);
#pragma unroll
  for (int r = 0; r < R; ++r) ss[r] = rsqrtf(ss[r] * (1.f / 1024.f) + EPSV);
#pragma unroll
  for (int j = 0; j < 4; ++j) {
    int col = lane * 4 + 256 * j;
    float4 gg = *(const float4*)(g + col);
    float4 sh = *(const float4*)(md + col);
    float4 sc = *(const float4*)(md + 1024 + col);
    float m0 = gg.x * (1.f + sc.x), m1 = gg.y * (1.f + sc.y), m2 = gg.z * (1.f + sc.z), m3 = gg.w * (1.f + sc.w);
#pragma unroll
    for (int r = 0; r < R; ++r)
      *(uint2*)(p.H + (size_t)(t0 + r * tstep) * LDK + col) =
          make_uint2(pack_bf16(v[r][j].x * ss[r] * m0 + sh.x, v[r][j].y * ss[r] * m1 + sh.y), pack_bf16(v[r][j].z * ss[r] * m2 + sh.z, v[r][j].w * ss[r] * m3 + sh.w));
  }
}
DI void norm_static(const Params& p, int layer, int which, int row0, int row1) {
  const int tid = tidx(), lane = tid & 63, wid = tid >> 6;
  for (int t = row0 + blockIdx.x * 8 + wid; t < row1; t += gridDim.x * 8) norm_row(p, layer, which, t, lane);
}
DI void norm_dyn(const Params& p, int layer, int which, int row0, int row1, unsigned* ctr) {
  const int tid = tidx(), lane = tid & 63, wid = tid >> 6;
  const int nchunk = (row1 - row0) >> 5;
  while (true) {
    int ch = grab(ctr);
    if (ch >= nchunk) break;
    norm_rows<4>(p, layer, which, row0 + ch * 32 + wid, 8, lane);
  }
}

namespace pg8 {
typedef unsigned short bf16_t;
constexpr int BM = 256, BK = 64, HALF = 128, HTB = HALF * BK * 2, STAGE_BYTES = 8 * HTB, NXCD = 8, WGM = 8;
DI int lds_byte(int r, int c) { const int st = (r >> 4) * 2 + (c >> 5), rr = r & 15, cc = c & 31, ob = rr * 64 + cc * 2; return st * 1024 + (ob ^ (((ob >> 9) & 1) << 5)); }
DI void stage_rc(int b, int& R, int& C) { const int st = b / 1024, sb = b % 1024, swz = sb ^ (((sb >> 9) & 1) << 5); R = (st >> 1) * 16 + swz / 64; C = (st & 1) * 32 + (swz % 64) / 2; }
DI int perm32(int rho) { const int n = rho >> 4, i = rho & 15; return 8 * (i >> 2) + 4 * n + (i & 3); }
struct Unit { int pm, pn; };
struct Gemm { const bf16_t* A; const bf16_t* Bt; int K; };

struct TileOrder {
  int nM, nN, nwg, G, c, remap;
  DI void init(int nM_, int nN_, int G_, int c_, int remap_) { nM = nM_; nN = nN_; nwg = nM * nN; G = G_; c = c_; remap = remap_; }
  DI bool next(int i, Unit& u) const {
    long L = (long)i * G + c;
    if (remap) {
      if (c >= 240) { if (i >= 3) return false; }
      else if (c >= 128 && c < 144 && i == 5) L = 4L * G + (c + 112);
      else if (c >= 144 && c < 160 && i == 5) L = 3L * G + (c + 96);
    }
    if (L >= nwg) return false;
    int wgid = (int)L; { const int q = nwg / NXCD, r = nwg % NXCD, xcd = wgid % NXCD, off = wgid / NXCD; wgid = (xcd < r ? xcd * (q + 1) : r * (q + 1) + (xcd - r) * q) + off; }
    const int nig = WGM * nN, gid = wgid / nig, fm = gid * WGM, gsz = (nM - fm) < WGM ? (nM - fm) : WGM;
    u.pm = fm + ((wgid % nig) % gsz); u.pn = (wgid % nig) / gsz; return true;
  }
};
struct OneUnit {
  Unit u; bool valid;
  DI bool next(int i, Unit& o) const { if (i != 0 || !valid) return false; o = u; return true; }
};

template <class Epi, class Sched>
DI void gemm_phase(LAS unsigned char* lds, const Gemm g, const Sched& S, const Epi& E) {
  const int tid = tidx(), wid = __builtin_amdgcn_readfirstlane(tid >> 6), lane = tid & 63, wr = wid >> 2, wc = wid & 3, fr = lane & 15, fq = lane >> 4;
  int K = g.K; asm volatile("" : "+s"(K));
  const int nt = K / BK;
  unsigned voffA[2], voffB[2];
#pragma unroll
  for (int i = 0; i < 2; ++i) {
    int R, C; stage_rc(tid * 16 + i * 8192, R, C);
    int Rb = R;
    if (Epi::BMAP == 1) Rb = (R & ~31) + perm32(R & 31);
    if (Epi::BMAP == 2) Rb = 64 * (R >> 5) + perm32(R & 31);
    voffA[i] = (unsigned)(R * K + C) * 2u; voffB[i] = (unsigned)(Rb * K + C) * 2u;
  }
  const size_t kstep = (size_t)(BK * 2);
  const size_t hstep = (size_t)HALF * K * 2;
  const size_t hstepB = (Epi::BMAP == 2) ? (size_t)32 * K * 2 : hstep;
  const size_t tstep = 2 * hstep;
  const unsigned ldsw = (unsigned)wid * 1024u;
  const int aoff = lds_byte(wr * 64 + fr, fq * 8), boff = lds_byte(wc * 32 + fr, fq * 8);
#define PG8_SA(b, h) (((b) * 2 + (h)) * HTB)
#define PG8_SB(b, h) ((4 + (b) * 2 + (h)) * HTB)
#define PG8_STAGE(bufoff, gbase, voff) do { _Pragma("unroll") for (int _i = 0; _i < 2; ++_i) \
    __builtin_amdgcn_global_load_lds((const unsigned*)((const char*)(gbase) + (voff)[_i]), (LAS unsigned*)(lds + (bufoff) + ldsw + _i * 8192), 16, 0, 0); } while (0)
#define PG8_LDA(dst, b, h) do { _Pragma("unroll") for (int m = 0; m < 4; ++m) _Pragma("unroll") for (int k = 0; k < 2; ++k) dst[m][k] = *(const LAS bf16x8*)(lds + PG8_SA(b, h) + aoff + m * 2048 + k * 1024); } while (0)
#define PG8_LDB(dst, b, h) do { _Pragma("unroll") for (int n = 0; n < 2; ++n) _Pragma("unroll") for (int k = 0; k < 2; ++k) dst[n][k] = *(const LAS bf16x8*)(lds + PG8_SB(b, h) + boff + n * 2048 + k * 1024); } while (0)
#define PG8_MMA(ai, bj, At, Bt) do { __builtin_amdgcn_s_setprio(1); _Pragma("unroll") for (int m = 0; m < 4; ++m) _Pragma("unroll") for (int n = 0; n < 2; ++n) _Pragma("unroll") for (int k = 0; k < 2; ++k) \
    acc[ai][bj][m][n] = __builtin_amdgcn_mfma_f32_16x16x32_bf16(Bt[n][k], At[m][k], acc[ai][bj][m][n], 0, 0, 0); __builtin_amdgcn_s_setprio(0); } while (0)
#define PG8_WAIT_V(n) asm volatile("s_waitcnt vmcnt(" #n ")" ::: "memory")
#define PG8_WAIT_L(n) asm volatile("s_waitcnt lgkmcnt(" #n ")" ::: "memory")
#define PG8_BAR __builtin_amdgcn_s_barrier()
#define PG8_SCHED __builtin_amdgcn_sched_barrier(0)
  Unit cur, nxt; int ui = 0;
  if (!S.next(0, cur)) return;
  f32x4 acc[2][2][4][2];
#pragma unroll
  for (int a = 0; a < 2; ++a)
#pragma unroll
    for (int b = 0; b < 2; ++b)
#pragma unroll
      for (int m = 0; m < 4; ++m)
#pragma unroll
        for (int n = 0; n < 2; ++n) acc[a][b][m][n] = (f32x4){0.f, 0.f, 0.f, 0.f};
  bf16x8 At[4][2], B0[2][2], B1[2][2];
  const char* cA = (const char*)g.A + (size_t)cur.pm * tstep; const char* cB = (const char*)g.Bt + (size_t)cur.pn * tstep;
  PG8_STAGE(PG8_SB(0, 0), cB, voffB); PG8_STAGE(PG8_SA(0, 0), cA, voffA); PG8_STAGE(PG8_SB(0, 1), cB + hstepB, voffB); PG8_STAGE(PG8_SA(0, 1), cA + hstep, voffA);
  if (wr == 1) PG8_BAR;
  PG8_WAIT_V(4); PG8_BAR;
  PG8_STAGE(PG8_SB(1, 0), cB + kstep, voffB); PG8_STAGE(PG8_SA(1, 0), cA + kstep, voffA); PG8_STAGE(PG8_SB(1, 1), cB + hstepB + kstep, voffB);
  PG8_WAIT_V(6); PG8_BAR;
  for (;;) {
    const bool has_next = S.next(ui + 1, nxt);
    const char* nA = has_next ? (const char*)g.A + (size_t)nxt.pm * tstep : cA; const char* nB = has_next ? (const char*)g.Bt + (size_t)nxt.pn * tstep : cB;
    for (int t = 0; t < nt; t += 2) {
      const bool last = (t == nt - 2);
      const char* a1 = cA + (size_t)(t + 1) * kstep;
      const char* a2 = last ? nA : cA + (size_t)(t + 2) * kstep; const char* b2 = last ? nB : cB + (size_t)(t + 2) * kstep;
      const char* a3 = a2 + kstep; const char* b3 = b2 + kstep;
      PG8_LDB(B0, 0, 0); PG8_SCHED; PG8_LDA(At, 0, 0); PG8_STAGE(PG8_SA(1, 1), a1 + hstep, voffA);
      PG8_WAIT_L(8); PG8_BAR; PG8_WAIT_L(0); PG8_MMA(0, 0, At, B0); PG8_BAR; PG8_SCHED;
      PG8_LDB(B1, 0, 1); PG8_STAGE(PG8_SB(0, 0), b2, voffB);
      PG8_BAR; PG8_WAIT_L(0); PG8_MMA(0, 1, At, B1); PG8_BAR;
      PG8_LDA(At, 0, 1); PG8_STAGE(PG8_SA(0, 0), a2, voffA);
      PG8_BAR; PG8_WAIT_L(0); PG8_MMA(1, 0, At, B0); PG8_BAR; PG8_SCHED;
      PG8_STAGE(PG8_SB(0, 1), b2 + hstepB, voffB);
      PG8_WAIT_V(6); PG8_BAR; PG8_MMA(1, 1, At, B1); PG8_BAR;
      PG8_LDB(B0, 1, 0); PG8_SCHED; PG8_LDA(At, 1, 0); PG8_STAGE(PG8_SA(0, 1), a2 + hstep, voffA);
      PG8_WAIT_L(8); PG8_BAR; PG8_WAIT_L(0); PG8_MMA(0, 0, At, B0); PG8_BAR; PG8_SCHED;
      PG8_LDB(B1, 1, 1); PG8_STAGE(PG8_SB(1, 0), b3, voffB);
      PG8_BAR; PG8_WAIT_L(0); PG8_MMA(0, 1, At, B1); PG8_BAR;
      PG8_LDA(At, 1, 1); PG8_STAGE(PG8_SA(1, 0), a3, voffA);
      PG8_BAR; PG8_WAIT_L(0); PG8_MMA(1, 0, At, B0); PG8_BAR; PG8_SCHED;
      PG8_STAGE(PG8_SB(1, 1), b3 + hstepB, voffB);
      PG8_WAIT_V(6); PG8_BAR; PG8_MMA(1, 1, At, B1); PG8_BAR;
    }
    E(acc, cur, wr, wc, fr, fq);
    if (!has_next) break;
#pragma unroll
    for (int a = 0; a < 2; ++a)
#pragma unroll
      for (int b = 0; b < 2; ++b)
#pragma unroll
        for (int m = 0; m < 4; ++m)
#pragma unroll
          for (int n = 0; n < 2; ++n) acc[a][b][m][n] = (f32x4){0.f, 0.f, 0.f, 0.f};
    cur = nxt; cA = nA; cB = nB; ++ui;
  }
  PG8_WAIT_V(0);
  if (wr == 0) PG8_BAR;
  PG8_BAR;
#undef PG8_SA
#undef PG8_SB
#undef PG8_STAGE
#undef PG8_LDA
#undef PG8_LDB
#undef PG8_MMA
#undef PG8_WAIT_V
#undef PG8_WAIT_L
#undef PG8_BAR
#undef PG8_SCHED
}

struct EpiRes {
  static constexpr int BMAP = 0;
  const float* src; float* dst; const float* gate;
  DI void operator()(const f32x4 (&acc)[2][2][4][2], const Unit& u, int wr, int wc, int fr, int fq) const {
    asm volatile("" ::: "memory");
    const int row0 = u.pm * BM + wr * 64 + fr, col0 = u.pn * BM + wc * 32 + 4 * fq;
    f32x4 gv[2][2];
#pragma unroll
    for (int bj = 0; bj < 2; ++bj)
#pragma unroll
      for (int n = 0; n < 2; ++n) gv[bj][n] = *(const f32x4*)(gate + col0 + bj * HALF + n * 16);
#pragma unroll
    for (int ai = 0; ai < 2; ++ai) {
      f32x4 sv[4][2][2];
#pragma unroll
      for (int m = 0; m < 4; ++m) {
        const size_t ro = (size_t)(row0 + ai * HALF + m * 16) * DM + col0;
#pragma unroll
        for (int bj = 0; bj < 2; ++bj)
#pragma unroll
          for (int n = 0; n < 2; ++n) sv[m][bj][n] = *(const f32x4*)(src + ro + bj * HALF + n * 16);
      }
#pragma unroll
      for (int m = 0; m < 4; ++m) {
        const size_t ro = (size_t)(row0 + ai * HALF + m * 16) * DM + col0;
#pragma unroll
        for (int bj = 0; bj < 2; ++bj)
#pragma unroll
          for (int n = 0; n < 2; ++n) *(f32x4*)(dst + ro + bj * HALF + n * 16) = sv[m][bj][n] + gv[bj][n] * acc[ai][bj][m][n];
      }
    }
  }
};
struct EpiGU {
  static constexpr int BMAP = 1;
  u16* act;
  DI void operator()(const f32x4 (&acc)[2][2][4][2], const Unit& u, int wr, int wc, int fr, int fq) const {
    asm volatile("" ::: "memory");
    const int row0 = u.pm * BM + wr * 64 + fr, col0 = u.pn * HALF + wc * 32 + 8 * fq;
#pragma unroll
    for (int ai = 0; ai < 2; ++ai)
#pragma unroll
      for (int m = 0; m < 4; ++m) {
        float a[8];
#pragma unroll
        for (int n = 0; n < 2; ++n)
#pragma unroll
          for (int e = 0; e < 4; ++e) {
            float gte = acc[ai][0][m][n][e], up = acc[ai][1][m][n][e];
            a[n * 4 + e] = gte * __builtin_amdgcn_rcpf(1.f + __builtin_amdgcn_exp2f(-gte * LOG2E)) * up;
          }
        *(uint4*)(act + (size_t)(row0 + ai * HALF + m * 16) * FFN + col0) =
            make_uint4(pack_bf16(a[0], a[1]), pack_bf16(a[2], a[3]), pack_bf16(a[4], a[5]), pack_bf16(a[6], a[7]));
      }
  }
};
struct EpiQKV {
  static constexpr int BMAP = 2;
  u16* qkv; const float* qkn; const float* rope; int rowbase;
  DI void operator()(const f32x4 (&acc)[2][2][4][2], const Unit& u, int wr, int wc, int fr, int fq) const {
    asm volatile("" ::: "memory");
    const int chunk = u.pn * 4 + wc;
    const bool isV = (chunk == 8 || chunk == 9 || (chunk >= 18 && chunk <= 21) || chunk >= 30);
    int gi = 0;
    if (chunk < 6) gi = 0; else if (chunk < 8) gi = 1; else if (chunk < 14) gi = 2; else if (chunk < 18) gi = 3;
    else if (chunk < 28) gi = 4; else gi = 5;
    const bool ropeT = (gi == 0 || gi == 1 || gi == 4 || gi == 5) && rowbase == 0;
    const float* gam = qkn + gi * 64;
    const float qs = (gi == 0 || gi == 2 || gi == 4) ? 0.125f * LOG2E : 1.f;
    f32x4 g4[2][2];
#pragma unroll
    for (int bj = 0; bj < 2; ++bj)
#pragma unroll
      for (int n = 0; n < 2; ++n) g4[bj][n] = *(const f32x4*)(gam + 32 * bj + 8 * fq + 4 * n);
#pragma unroll
    for (int ai = 0; ai < 2; ++ai) {
#pragma unroll
     for (int mp = 0; mp < 2; ++mp) {
      f32x4 csr[2][2][2];
      if (ropeT && !isV) {
#pragma unroll
        for (int m2 = 0; m2 < 2; ++m2) {
          const int tt = u.pm * BM + ai * HALF + wr * 64 + (2 * mp + m2) * 16 + fr;
          const float* rp = rope + (size_t)(tt & 4095) * 64 + 2 * (8 * fq);
#pragma unroll
          for (int n = 0; n < 2; ++n) { csr[m2][n][0] = *(const f32x4*)(rp + 8 * n); csr[m2][n][1] = *(const f32x4*)(rp + 8 * n + 4); }
        }
      }
#pragma unroll
      for (int m = 2 * mp; m < 2 * mp + 2; ++m) {
        const int t = u.pm * BM + ai * HALF + wr * 64 + m * 16 + fr;
        int b, pos;
        if (rowbase == 0) { b = t >> 12; pos = t & 4095; } else { b = t >> 8; pos = 4096 + (t & 255); }
        u16* base = qkv + (size_t)(b * 32 + chunk) * LTOT * 64;
        if (isV) {
#pragma unroll
          for (int bj = 0; bj < 2; ++bj)
#pragma unroll
            for (int n = 0; n < 2; ++n)
#pragma unroll
              for (int e = 0; e < 4; ++e) {
                int d = 32 * bj + 8 * fq + 4 * n + e;
                base[(size_t)d * LTOT + pos] = f2bf(acc[ai][bj][m][n][e]);
              }
        } else {
          float ss = 0.f;
#pragma unroll
          for (int bj = 0; bj < 2; ++bj)
#pragma unroll
            for (int n = 0; n < 2; ++n)
#pragma unroll
              for (int e = 0; e < 4; ++e) ss += acc[ai][bj][m][n][e] * acc[ai][bj][m][n][e];
          ss += __shfl_xor(ss, 16);
          ss += __shfl_xor(ss, 32);
          const float rinv = rsqrtf(ss * (1.f / 64.f) + EPSV);
          float o1[8], o2[8];
#pragma unroll
          for (int n = 0; n < 2; ++n) {
            f32x4 cs0 = (f32x4){1.f, 0.f, 1.f, 0.f}, cs1 = cs0;
            if (ropeT) { cs0 = csr[m & 1][n][0]; cs1 = csr[m & 1][n][1]; }
#pragma unroll
            for (int e = 0; e < 4; ++e) {
              float x1 = acc[ai][0][m][n][e] * (rinv * qs) * g4[0][n][e];
              float x2 = acc[ai][1][m][n][e] * (rinv * qs) * g4[1][n][e];
              float c = (e < 2) ? cs0[2 * e] : cs1[2 * (e - 2)], s = (e < 2) ? cs0[2 * e + 1] : cs1[2 * (e - 2) + 1];
              o1[n * 4 + e] = x1 * c - x2 * s;
              o2[n * 4 + e] = x2 * c + x1 * s;
            }
          }
          u16* dst = base + (size_t)pos * 64 + 8 * fq;
          *(uint4*)(dst) = make_uint4(pack_bf16(o1[0], o1[1]), pack_bf16(o1[2], o1[3]), pack_bf16(o1[4], o1[5]), pack_bf16(o1[6], o1[7]));
          *(uint4*)(dst + 32) = make_uint4(pack_bf16(o2[0], o2[1]), pack_bf16(o2[2], o2[3]), pack_bf16(o2[4], o2[5]), pack_bf16(o2[6], o2[7]));
        }
      }
     }
    }
  }
};
}

constexpr int KROW = 144, VROW = 144;
constexpr int KT_B = 64 * KROW, VT_B = 64 * VROW, KV_B = KT_B + VT_B;
constexpr int RPB_OFF = 2 * KV_B;
constexpr int NAT_C = 384, NAT_B = 256, NAT_A = 384, NAT_LAT = NAT_C + NAT_B + NAT_A, NAT_CTX = 64;

DI void attn_item(const Params& p, int layer, int item, char* smem) {
  const int tid = tidx(), lane = tid & 63, wid = tid >> 6, l32 = lane & 31, h = lane >> 5;
  int mode, b, hh, qb;
  if (item < NAT_C) { mode = 0; b = item / 96; int rem = item % 96; hh = rem >> 4; qb = rem & 15; }
  else if (item < NAT_C + NAT_B) { int it = item - NAT_C; mode = 1; b = it >> 6; hh = (it & 63) >> 4; qb = it & 15; }
  else if (item < NAT_LAT) { int it = item - NAT_C - NAT_B; mode = 2; b = it / 96; int rem = it % 96; hh = rem >> 4; qb = rem & 15; }
  else { int it = item - NAT_LAT; mode = 3; b = it >> 4; hh = it & 15; qb = 0; }

  int qchunk, kchunk, vchunk, head16, t0 = 0, t1 = 0, qpos0 = qb * 256;
  bool hasSink = false; float sinkv = 0.f;
  int maskmode = 0;
  if (mode == 0) { qchunk = 22 + hh; kchunk = 28 + hh / 3; vchunk = 30 + hh / 3; head16 = 10 + hh; t0 = 0; t1 = 64; }
  else if (mode == 1) {
    qchunk = 10 + hh; kchunk = 14 + hh; vchunk = 18 + hh; head16 = 6 + hh; maskmode = 1;
    t0 = min(max(4 * qb - 4, 0), 56); t1 = min(max(4 * qb + 3 - 4, 0), 56) + 8;
  } else if (mode == 2) {
    qchunk = hh; kchunk = 6 + hh / 3; vchunk = 8 + hh / 3; head16 = hh; maskmode = 2;
    t0 = max(0, 4 * qb - 2); t1 = min(64, 4 * qb + 6); hasSink = true; sinkv = p.sink[layer * 6 + hh];
  } else {
    head16 = hh; qpos0 = 4096;
    if (hh < 6) { qchunk = hh; kchunk = 6 + hh / 3; vchunk = 8 + hh / 3; hasSink = true; sinkv = p.sink[layer * 6 + hh]; }
    else if (hh < 10) { int hb = hh - 6; qchunk = 10 + hb; kchunk = 14 + hb; vchunk = 18 + hb; }
    else { int hc = hh - 10; qchunk = 22 + hc; kchunk = 28 + hc / 3; vchunk = 30 + hc / 3; }
  }
  const int n_it = 4 + (t1 - t0);
  const u16* Qb = p.QKV + (size_t)(b * 32 + qchunk) * LTOT * 64;
  const u16* Kb = p.QKV + (size_t)(b * 32 + kchunk) * LTOT * 64;
  const u16* Vb = p.QKV + (size_t)(b * 32 + vchunk) * LTOT * 64;
  float* s_rpb = (float*)(smem + RPB_OFF);
  if (mode == 1) {
    const float* rp = p.rpb + (size_t)(layer * 4 + hh) * 465;
    for (int e = tid; e < 465; e += NTHR) s_rpb[e] = rp[e] * LOG2E;
  }

  const int qpos = qpos0 + wid * 32 + l32;
  bf16x8 qf[4];
#pragma unroll
  for (int s = 0; s < 4; ++s) qf[s] = *(const bf16x8*)(Qb + (size_t)qpos * 64 + s * 16 + h * 8);

  f32x16 o0, o1;
#pragma unroll
  for (int r = 0; r < 16; ++r) { o0[r] = 0.f; o1[r] = 0.f; }
  const int btype = (mode == 3) ? (hh < 6 ? 0 : (hh < 10 ? 1 : 2)) : (mode == 0 ? 2 : (mode == 1 ? 1 : 0));
  float m_fix = p.bounds[layer * 8 + btype];
  if (mode == 1) m_fix += p.bounds[layer * 8 + 4 + hh];
  f32x16 cinit, lacc;
#pragma unroll
  for (int r = 0; r < 16; ++r) { cinit[r] = -m_fix; lacc[r] = 0.f; }
  const bf16x8 ones = {(short)0x3F80, (short)0x3F80, (short)0x3F80, (short)0x3F80, (short)0x3F80, (short)0x3F80, (short)0x3F80, (short)0x3F80};

  const int lr = tid >> 3, lc = tid & 7;
  uint4 ka0, va0, kb0, vb0;
#define TILE_OF(it) ((it) < 4 ? 64 + (it) : t0 + (it) - 4)
#define AGLOAD(K0, V0, tile)                                                           \
  {                                                                                    \
    K0 = *(const uint4*)(Kb + (size_t)((tile) * 64 + lr) * 64 + lc * 8);               \
    V0 = *(const uint4*)(Vb + (size_t)(lr) * LTOT + (tile) * 64 + lc * 8);             \
  }
#define ASWRITE(K0, V0, buf)                                                           \
  {                                                                                    \
    *(uint4*)(smem + (buf) * KV_B + (lr) * KROW + lc * 16) = K0;                       \
      \
                       \
    char* vd = smem + (buf) * KV_B + KT_B + (lr) * VROW + (16 * (lc >> 1) + 4 * (lc & 1)) * 2; \
    *(uint2*)(vd) = make_uint2(V0.x, V0.y);                                            \
    *(uint2*)(vd + 16) = make_uint2(V0.z, V0.w);                                       \
  }

  const int tq = qb * 256 + wid * 32 + l32;
  auto compute = [&](const int bufsel, const int tile) {
    bool skip = false;
    if (tile < 64) {
      if (maskmode == 1) {
        int qr = (qb * 256 + wid * 32) >> 6;
        int krw = min(max(qr - 4, 0), 56);
        skip = (tile < krw) || (tile >= krw + 8);
      } else if (maskmode == 2) {
        int q0w = qb * 256 + wid * 32, tk0 = tile * 64;
        skip = (tk0 > q0w + 31 + 128) || (tk0 + 63 < q0w - 128);
      }
    }
    if (!skip) {
      const char* sK = smem + bufsel * KV_B;
      const char* sV = sK + KT_B;
      f32x16 S[2];
      __builtin_amdgcn_s_setprio(1);
#pragma unroll
      for (int kt = 0; kt < 2; ++kt) {
#pragma unroll
        for (int s = 0; s < 4; ++s) {
          bf16x8 kf = *(const bf16x8*)(sK + (kt * 32 + l32) * KROW + s * 32 + h * 16);
          S[kt] = MFMA32(kf, qf[s], s == 0 ? cinit : S[kt]);
        }
      }
      __builtin_amdgcn_s_setprio(0);
      if (tile < 64 && maskmode == 1) {
        int qr = tq >> 6, qc = tq & 63;
        int ws = min(max(qc - 8, 0), 48);
        int dr = tile - qr + 7;
#pragma unroll
        for (int kt = 0; kt < 2; ++kt)
#pragma unroll
          for (int r = 0; r < 16; ++r) {
            int kc = kt * 32 + crow(r, h);
            bool ok = (unsigned)(kc - ws) < 16u;
            int bi = ok ? (dr * 31 + kc - qc + 15) : 0;
            float bv = s_rpb[bi];
            S[kt][r] = ok ? (S[kt][r] + bv) : -INFINITY;
          }
      } else if (tile < 64 && maskmode == 2) {
#pragma unroll
        for (int kt = 0; kt < 2; ++kt)
#pragma unroll
          for (int r = 0; r < 16; ++r) {
            int tk = tile * 64 + kt * 32 + crow(r, h);
            int dd = tq - tk;
            bool ok = (dd <= 128) && (dd >= -128);
            S[kt][r] = ok ? S[kt][r] : -INFINITY;
          }
      }
#pragma unroll
      for (int r = 0; r < 16; ++r) {
        S[0][r] = __builtin_amdgcn_exp2f(S[0][r]);
        S[1][r] = __builtin_amdgcn_exp2f(S[1][r]);
      }
#pragma unroll
      for (int kt = 0; kt < 2; ++kt)
#pragma unroll
        for (int s2 = 0; s2 < 2; ++s2) {
          uint4 pw;
          pw.x = pack_bf16(S[kt][8 * s2 + 0], S[kt][8 * s2 + 1]);
          pw.y = pack_bf16(S[kt][8 * s2 + 2], S[kt][8 * s2 + 3]);
          pw.z = pack_bf16(S[kt][8 * s2 + 4], S[kt][8 * s2 + 5]);
          pw.w = pack_bf16(S[kt][8 * s2 + 6], S[kt][8 * s2 + 7]);
          bf16x8 pf = __builtin_bit_cast(bf16x8, pw);
          const int koff = (kt * 32 + 16 * s2 + 8 * h) * 2;
          {
            bf16x8 vf = *(const bf16x8*)(sV + l32 * VROW + koff);
            o0 = MFMA32(vf, pf, o0);
            lacc = MFMA32(ones, pf, lacc);
          }
          {
            bf16x8 vf = *(const bf16x8*)(sV + (32 + l32) * VROW + koff);
            o1 = MFMA32(vf, pf, o1);
          }
        }
    }
  };

  AGLOAD(ka0, va0, TILE_OF(0));
  if (n_it > 1) { AGLOAD(kb0, vb0, TILE_OF(1)); }
  ASWRITE(ka0, va0, 0);
  if (n_it > 2) { AGLOAD(ka0, va0, TILE_OF(2)); }
  __syncthreads();
  for (int it = 0; it < n_it; it += 2) {
    if (it + 1 < n_it) { ASWRITE(kb0, vb0, 1); }
    if (it + 3 < n_it) { AGLOAD(kb0, vb0, TILE_OF(it + 3)); }
    __builtin_amdgcn_sched_barrier(0);
    compute(0, TILE_OF(it));
    __syncthreads();
    if (it + 1 < n_it) {
      if (it + 2 < n_it) { ASWRITE(ka0, va0, 0); }
      if (it + 4 < n_it) { AGLOAD(ka0, va0, TILE_OF(it + 4)); }
      __builtin_amdgcn_sched_barrier(0);
      compute(1, TILE_OF(it + 1));
      __syncthreads();
    }
  }
#undef AGLOAD
#undef ASWRITE
#undef TILE_OF

  float l_tot = lacc[0];
  if (hasSink) l_tot += __builtin_amdgcn_exp2f(sinkv * LOG2E - m_fix);
  float inv = 1.f / l_tot;
  int T = (mode == 3) ? (TLAT + b * 256 + (qpos - 4096)) : (b * 4096 + qpos);
  u16* od = p.O + (size_t)T * LDK + head16 * 64;
#pragma unroll
  for (int g = 0; g < 4; ++g) {
    int d0 = 8 * g + 4 * h;
    *(uint2*)(od + d0) = make_uint2(pack_bf16(o0[4 * g] * inv, o0[4 * g + 1] * inv), pack_bf16(o0[4 * g + 2] * inv, o0[4 * g + 3] * inv));
    *(uint2*)(od + 32 + d0) = make_uint2(pack_bf16(o1[4 * g] * inv, o1[4 * g + 1] * inv), pack_bf16(o1[4 * g + 2] * inv, o1[4 * g + 3] * inv));
  }
}

DI void run_gphase(const Params& p, int g, char* smem, int coff = 0) {
  using namespace pg8;
  LAS unsigned char* lds = (LAS unsigned char*)smem;
  const int layer = (g - 1) / 7, ph = (g - 1) % 7 + 1;
  const bool hasc = (g + 1 <= 23);
  const int cl = g / 7;
  const int bid = blockIdx.x, nb = gridDim.x;
  const float* xin_lat; const float* xin_ctx; float* xo_lat = p.out; float* xo_ctx = p.xctx;
  { const float* a_ = p.x; const float* c_ = p.ctx; asm volatile("" : "+s"(a_), "+s"(c_));
    float* b_ = p.out; float* d_ = p.xctx; asm volatile("" : "+s"(b_), "+s"(d_));
    xin_lat = (layer == 0) ? a_ : (const float*)b_; xin_ctx = (cl == 0) ? c_ : (const float*)d_; xo_lat = b_; xo_ctx = d_; }
  switch (ph) {
    case 1: {
      if (hasc) {
        OneUnit S; S.u.pm = bid & 3; S.u.pn = bid >> 2; S.valid = bid < 32;
        EpiQKV E; E.qkv = p.QKV; E.qkn = p.qk_norm + cl * 6 * 64; E.rope = p.rope; E.rowbase = TLAT;
        gemm_phase(lds, Gemm{p.H + (size_t)TLAT * LDK, p.wt_in + (size_t)cl * INW * LDK, DM}, S, E);
      }
      norm_dyn(p, layer, 0, 0, TLAT, &p.counters[32 + g + coff]);
    } break;
    case 2: {
      TileOrder S; S.init(64, 8, nb, bid, 0);
      EpiQKV E; E.qkv = p.QKV; E.qkn = p.qk_norm + layer * 6 * 64; E.rope = p.rope; E.rowbase = 0;
      gemm_phase(lds, Gemm{p.H, p.wt_in + (size_t)layer * INW * LDK, DM}, S, E);
      if (hasc)
        for (int i = bid; i < NAT_CTX; i += nb) attn_item(p, cl, NAT_LAT + i, smem);
    } break;
    case 3: {
      const int nctx = hasc ? 16 : 0;
      for (int it = grab(&p.counters[g + coff]); it < NAT_LAT + nctx; it = grab(&p.counters[g + coff])) {
        if (it < NAT_C) attn_item(p, layer, it, smem);
        else if (it < NAT_C + nctx) {
          int j = it - NAT_C;
          OneUnit S; S.u.pm = j & 3; S.u.pn = j >> 2; S.valid = true;
          EpiRes E; E.src = xin_ctx; E.dst = xo_ctx; E.gate = p.mod + ((size_t)cl * 5 + 4) * 6144 + 2 * 1024;
          gemm_phase(lds, Gemm{p.O + (size_t)TLAT * LDK, p.wt_out + (size_t)cl * DM * LDK, DM}, S, E);
        } else attn_item(p, layer, it - nctx, smem);
      }
    } break;
    case 4: {
      TileOrder S; S.init(64, 4, nb, bid, 0);
      Unit u0;
      for (int i = 0; S.next(i, u0); ++i) {
        OneUnit S1; S1.u = u0; S1.valid = true;
        EpiRes E; E.src = xin_lat; E.dst = xo_lat; E.gate = p.mod + ((size_t)layer * 5 + (u0.pm >> 4)) * 6144 + 2 * 1024;
        gemm_phase(lds, Gemm{p.O, p.wt_out + (size_t)layer * DM * LDK, DM}, S1, E);
      }
      if (hasc) norm_static(p, cl, 1, TLAT, TTOT);
    } break;
    case 5: {
      if (hasc) {
        OneUnit S; S.u.pm = bid & 3; S.u.pn = bid >> 2; S.valid = bid < 88;
        EpiGU E; E.act = p.ACT + (size_t)TLAT * LDF;
        gemm_phase(lds, Gemm{p.H + (size_t)TLAT * LDK, p.wt_gu + (size_t)cl * GUW * LDK, DM}, S, E);
      }
      norm_dyn(p, layer, 1, 0, TLAT, &p.counters[32 + g + coff]);
    } break;
    case 6: {
      if (hasc) {
        int j = (nb == 256) ? bid - 240 : bid;
        OneUnit S; S.u.pm = j & 3; S.u.pn = (j >> 2) & 3; S.valid = (j >= 0 && j < 16);
        EpiRes E; E.src = xo_ctx; E.dst = xo_ctx; E.gate = p.mod + ((size_t)cl * 5 + 4) * 6144 + 5 * 1024;
        gemm_phase(lds, Gemm{p.ACT + (size_t)TLAT * LDF, p.wt_down + (size_t)cl * DM * LDF, FFN}, S, E);
      }
      TileOrder S; S.init(64, 22, nb, bid, (hasc && nb == 256) ? 1 : 0);
      EpiGU E; E.act = p.ACT;
      gemm_phase(lds, Gemm{p.H, p.wt_gu + (size_t)layer * GUW * LDK, DM}, S, E);
    } break;
    case 7: {
      TileOrder S; S.init(64, 4, nb, bid, 0);
      Unit u0;
      for (int i = 0; S.next(i, u0); ++i) {
        OneUnit S1; S1.u = u0; S1.valid = true;
        EpiRes E; E.src = xo_lat; E.dst = xo_lat; E.gate = p.mod + ((size_t)layer * 5 + (u0.pm >> 4)) * 6144 + 5 * 1024;
        gemm_phase(lds, Gemm{p.ACT, p.wt_down + (size_t)layer * DM * LDF, FFN}, S1, E);
      }
      if (hasc) norm_static(p, cl, 0, TLAT, TTOT);
    } break;
  }
}

#define XB_XCNT(j)  (256  + 64 * (j))
#define XB_XSUB(j)  (1280 + 64 * (j))
#define XB_XGEN(j)  (2304 + 64 * (j))
#define XB_TOP      3328
#define XB_TOPGEN   3392
#define XCD_BAR_WORDS 3456
#define LAS __attribute__((address_space(3)))
DI unsigned xb_ld(unsigned* p) { return __hip_atomic_load(p, __ATOMIC_RELAXED, __HIP_MEMORY_SCOPE_AGENT); }
DI unsigned xb_add(unsigned* p, unsigned v) { return __hip_atomic_fetch_add(p, v, __ATOMIC_RELAXED, __HIP_MEMORY_SCOPE_AGENT); }
DI unsigned xb_xcc_id() { return (unsigned)__builtin_amdgcn_s_getreg((3 << 11) | 20) & 0xFu; }
struct XcdBarrier { unsigned* bar; unsigned x; volatile LAS unsigned* st; };
DI XcdBarrier xcd_barrier_post(unsigned* bar, volatile LAS unsigned* st) {
  XcdBarrier b; b.bar = bar; b.x = xb_xcc_id(); b.st = st;
  if (threadIdx.x == 0) (void)xb_add(&bar[XB_XCNT(b.x)], 1u);
  return b;
}
DI void xcd_barrier_complete(unsigned* bar, unsigned x, unsigned& nloc, unsigned& nx) {
  const unsigned G = gridDim.x;
  unsigned sum, cnt, mine;
  for (;;) {
    sum = 0u; cnt = 0u; mine = 0u;
#pragma unroll
    for (unsigned j = 0; j < 16; ++j) { const unsigned c = xb_ld(&bar[XB_XCNT(j)]); sum += c; cnt += (c > 0u) ? 1u : 0u; mine = (j == x) ? c : mine; }
    if (sum == G) break;
    __builtin_amdgcn_s_sleep(1);
  }
  nloc = mine > 0u ? mine : 1u; nx = cnt > 0u ? cnt : 1u;
}
DI void xcd_barrier(const XcdBarrier& b) {
  asm volatile("s_waitcnt vmcnt(0)" ::: "memory");
  __syncthreads();
  if (threadIdx.x == 0) {
    unsigned* bar = b.bar;
    unsigned bx = b.x;
    asm volatile("" : "+s"(bx));
    __builtin_amdgcn_s_waitcnt(0);
    unsigned nloc = b.st[0], nx = b.st[1];
    if (nloc == 0u) { xcd_barrier_complete(bar, bx, nloc, nx); b.st[0] = nloc; b.st[1] = nx; }
    const unsigned old = xb_add(&bar[XB_XSUB(bx)], 1u);
    const unsigned gen = old / nloc;
    if (old + 1u == (gen + 1u) * nloc) {
      __builtin_amdgcn_fence(__ATOMIC_RELEASE, "agent");
      asm volatile("s_waitcnt vmcnt(0)" ::: "memory");
      const unsigned og = xb_add(&bar[XB_TOP], 1u);
      const unsigned tg = og / nx;
      if (og + 1u == (tg + 1u) * nx) xb_add(&bar[XB_TOPGEN], 1u);
      else { while (xb_ld(&bar[XB_TOPGEN]) == tg) __builtin_amdgcn_s_sleep(1); }
      __builtin_amdgcn_fence(__ATOMIC_ACQUIRE, "agent");
      xb_add(&bar[XB_XGEN(bx)], 1u);
      asm volatile("s_waitcnt vmcnt(0)" ::: "memory");
    } else {
      while (xb_ld(&bar[XB_XGEN(bx)]) == gen) __builtin_amdgcn_s_sleep(1);
      __builtin_amdgcn_fence(__ATOMIC_ACQUIRE, "agent");
      asm volatile("s_waitcnt vmcnt(0)" ::: "memory");
    }
  }
  __syncthreads();
}


__global__ void __launch_bounds__(512, 2) fwd_megakernel(Params p) {
  extern __shared__ __attribute__((aligned(16))) unsigned char dsm[];
  char* smem = (char*)dsm;
  cg::grid_group grid = cg::this_grid();
  if (threadIdx.x == 0) *(uint4*)(dsm + 131072) = make_uint4(0u, 0u, 0u, 0u);
  __syncthreads();
  XcdBarrier xb = xcd_barrier_post(p.counters + 1024, (volatile LAS unsigned*)(dsm + 131072));
  phase0(p, smem);
  grid.sync();
  norm_static(p, 0, 0, TLAT, TTOT);
  xcd_barrier(xb);
  for (int g = 1; g <= 7 * NLAYER; ++g) {
    run_gphase(p, g, smem);
#ifdef PROBE_DOUBLE
    if ((g - 1) % 7 + 1 == PROBE_DOUBLE) { xcd_barrier(xb); run_gphase(p, g, smem, 100); }
#endif
    if (g < 7 * NLAYER) xcd_barrier(xb);
  }
}

extern "C" void kernel_launch(void* const* d_in, const int* in_sizes, int n_in, void* d_out, int out_size, void* d_ws,
                              size_t ws_size, hipStream_t stream) {
  Params p{};
  p.x = (const float*)d_in[0]; p.c = (const float*)d_in[1]; p.ctx = (const float*)d_in[2]; p.c_ctx = (const float*)d_in[3];
  p.w_mod = (const float*)d_in[4]; p.b_mod = (const float*)d_in[5]; p.norm_attn = (const float*)d_in[6];
  p.norm_ffn = (const float*)d_in[7]; p.w_in = (const float*)d_in[8]; p.qk_norm = (const float*)d_in[9];
  p.sink = (const float*)d_in[10]; p.rpb = (const float*)d_in[11]; p.w_out = (const float*)d_in[12];
  p.w_gate = (const float*)d_in[13]; p.w_up = (const float*)d_in[14]; p.w_down = (const float*)d_in[15];
  p.out = (float*)d_out;
  char* w = (char*)d_ws;
  size_t off = 0;
  auto take = [&](size_t bytes) { char* r = w + off; off += (bytes + 255) & ~(size_t)255; return r; };
  p.counters = (unsigned*)take(4096 + XCD_BAR_WORDS * 4);
  p.wt_in = (u16*)take((size_t)NLAYER * INW * LDK * 2);
  p.wt_out = (u16*)take((size_t)NLAYER * DM * LDK * 2);
  p.wt_gu = (u16*)take((size_t)NLAYER * GUW * LDK * 2);
  p.wt_down = (u16*)take((size_t)NLAYER * DM * LDF * 2);
  p.H = (u16*)take((size_t)TTOT * LDK * 2);
  p.mod = (float*)take((size_t)NLAYER * 5 * 6144 * 4);
  p.xctx = (float*)take((size_t)TCTX * DM * 4);
  p.rope = (float*)take((size_t)SEQL * 32 * 2 * 4);
  p.bounds = (float*)take(256);
  p.QKV = (u16*)take((size_t)NBATCH * 32 * LTOT * 64 * 2);
  p.O = (u16*)take((size_t)TTOT * LDK * 2);
  p.ACT = p.QKV;

  hipMemsetAsync(p.counters, 0, 4096 + XCD_BAR_WORDS * 4, stream);

  static int grid_blocks = 0;
  if (!grid_blocks) {
    int dev = 0, cus = 0, per_cu = 0;
    hipGetDevice(&dev);
    hipDeviceGetAttribute(&cus, hipDeviceAttributeMultiprocessorCount, dev);
    hipFuncSetAttribute((const void*)fwd_megakernel, hipFuncAttributeMaxDynamicSharedMemorySize, DYN_LDS);
    hipOccupancyMaxActiveBlocksPerMultiprocessor(&per_cu, fwd_megakernel, NTHR, DYN_LDS);
    if (per_cu > 1) per_cu = 1;
    if (per_cu < 1) per_cu = 1;
    grid_blocks = cus * per_cu;
  }
  void* args[] = {&p};
  hipError_t e = hipLaunchCooperativeKernel((void*)fwd_megakernel, dim3(grid_blocks), dim3(NTHR), args, DYN_LDS, stream);
  if (e != hipSuccess) fprintf(stderr, "cooperative launch failed: %s (grid %d)\n", hipGetErrorString(e), grid_blocks);
}
```
